# Optimizing an MI355X kernel written in HIP

```python
import jax, jax.numpy as jnp
from jax import lax
import numpy as np

D_MODEL = 2048
BATCH = 16
SEQ = 2048
DEPTH = 4

GRID_W = 64
CTX_LEN = 256
N_MIXERS = 2
N_POOL_LAYERS = (DEPTH + N_MIXERS - 1) // N_MIXERS
N_ATTN_LAYERS = DEPTH // N_MIXERS
POOL_WINDOWS = (2, 4, 8, 16)
N_POOL_GROUPS = len(POOL_WINDOWS)
POOL_GROUP_DIM = D_MODEL // N_POOL_GROUPS
HEAD_DIM = 64
N_HEADS = D_MODEL // HEAD_DIM
N_KV_HEADS = N_HEADS // 8
GQA_GROUP = N_HEADS // N_KV_HEADS
ATTN_DIM = N_HEADS * HEAD_DIM
KV_DIM = N_KV_HEADS * HEAD_DIM
WINDOW = 128
Q_BLOCK = 128
KEY_SPAN = Q_BLOCK + 2 * WINDOW
AXIS_ROPE_DIM = HEAD_DIM // 2
ROPE_BASE = 10000.0
D_FF = -(-8 * D_MODEL // (3 * 256)) * 256
RMS_EPS = 1e-6
NEG_INF = -1e30

kernel_name = 'hybrid_pool_swa_dit_trunk'


def rms_norm(x, g):
    xf = x.astype(jnp.float32)
    y = xf * lax.rsqrt(jnp.mean(xf * xf, axis=-1, keepdims=True) + RMS_EPS)
    return (y * g.astype(jnp.float32)).astype(x.dtype)


def modulate(x, shift, scale):
    return x * (1 + scale) + shift


def axial_rope_tables(L):
    rows_n = L // GRID_W
    row = jnp.repeat(jnp.arange(rows_n), GRID_W).astype(jnp.float32)
    col = jnp.tile(jnp.arange(GRID_W), rows_n).astype(jnp.float32)
    inv = 1.0 / (ROPE_BASE ** (jnp.arange(0, AXIS_ROPE_DIM, 2, dtype=jnp.float32) / AXIS_ROPE_DIM))
    ang_r = row[:, None] * inv[None, :]
    ang_c = col[:, None] * inv[None, :]
    ang = jnp.concatenate([ang_r, ang_r, ang_c, ang_c], axis=-1)
    return jnp.cos(ang), jnp.sin(ang)


def _rotate_half(x):
    x1, x2 = jnp.split(x, 2, axis=-1)
    return jnp.concatenate([-x2, x1], axis=-1)


def apply_axial_rope(x, cos, sin):
    L = x.shape[1]
    bshape = (L,) + (1,) * (x.ndim - 3) + (HEAD_DIM,)
    xf = x.astype(jnp.float32)
    rot = jnp.concatenate([_rotate_half(xf[..., :AXIS_ROPE_DIM]), _rotate_half(xf[..., AXIS_ROPE_DIM:])], axis=-1)
    return (xf * cos.reshape(bshape) + rot * sin.reshape(bshape)).astype(x.dtype)


def multiscale_pool_mixer(h, w_pool, pool_scale):
    B, L, _ = h.shape
    hf = h.astype(jnp.float32)
    cs = jnp.concatenate([jnp.zeros((B, 1, D_MODEL), jnp.float32), jnp.cumsum(hf, axis=1)], axis=1)
    t = jnp.arange(L)
    parts = []
    for g, w in enumerate(POOL_WINDOWS):
        lo = jnp.clip(t - w // 2, 0, L)
        hi = jnp.clip(t + w // 2, 0, L)
        sl = slice(g * POOL_GROUP_DIM, (g + 1) * POOL_GROUP_DIM)
        csg = cs[..., sl]
        mean = (csg[:, hi] - csg[:, lo]) / (hi - lo).astype(jnp.float32)[None, :, None]
        parts.append(mean - hf[..., sl])
    p = jnp.stack(parts, axis=2)
    y = jnp.einsum('blgc,gcd->blgd', p, w_pool.astype(jnp.float32)).reshape(B, L, D_MODEL)
    return (y * pool_scale.astype(jnp.float32)).astype(h.dtype)


def _split_qkv(t, w_qkv):
    B, n, _ = t.shape
    qkv = t @ w_qkv
    q = qkv[..., :ATTN_DIM].reshape(B, n, N_KV_HEADS, GQA_GROUP, HEAD_DIM)
    k = qkv[..., ATTN_DIM:ATTN_DIM + KV_DIM].reshape(B, n, N_KV_HEADS, HEAD_DIM)
    v = qkv[..., ATTN_DIM + KV_DIM:].reshape(B, n, N_KV_HEADS, HEAD_DIM)
    return q, k, v


def windowed_gqa_mixer(h, hc, w_qkv, w_o, sinks, cos, sin, with_ctx_out):
    B, L, _ = h.shape
    Lc = hc.shape[1]
    scale = HEAD_DIM ** -0.5
    q, k, v = _split_qkv(h, w_qkv)
    qc, kc, vc = _split_qkv(hc, w_qkv)
    q = apply_axial_rope(q, cos, sin) * scale
    k = apply_axial_rope(k, cos, sin)
    qc = qc * scale
    pad = ((0, 0), (WINDOW, WINDOW), (0, 0), (0, 0))
    kp = jnp.pad(k, pad)
    vp = jnp.pad(v, pad)
    sink = sinks.astype(jnp.float32).reshape(1, N_KV_HEADS, GQA_GROUP, 1, 1)

    def attend_block(b):
        start = b * Q_BLOCK
        qb = lax.dynamic_slice_in_dim(q, start, Q_BLOCK, axis=1)
        kb = lax.dynamic_slice_in_dim(kp, start, KEY_SPAN, axis=1)
        vb = lax.dynamic_slice_in_dim(vp, start, KEY_SPAN, axis=1)
        s_loc = jnp.einsum('bqhgd,bkhd->bhgqk', qb, kb, preferred_element_type=jnp.float32)
        qpos = start + jnp.arange(Q_BLOCK)
        kpos = start - WINDOW + jnp.arange(KEY_SPAN)
        valid = (jnp.abs(qpos[:, None] - kpos[None, :]) <= WINDOW) & (kpos >= 0)[None, :] & (kpos < L)[None, :]
        s_loc = jnp.where(valid, s_loc, NEG_INF)
        s_ctx = jnp.einsum('bqhgd,bkhd->bhgqk', qb, kc, preferred_element_type=jnp.float32)
        s_snk = jnp.broadcast_to(sink, s_loc.shape[:-1] + (1,))
        p = jax.nn.softmax(jnp.concatenate([s_loc, s_ctx, s_snk], axis=-1), axis=-1)
        o = (jnp.einsum('bhgqk,bkhd->bqhgd', p[..., :KEY_SPAN].astype(v.dtype), vb)
             + jnp.einsum('bhgqk,bkhd->bqhgd', p[..., KEY_SPAN:KEY_SPAN + Lc].astype(v.dtype), vc))
        return o

    o = lax.map(attend_block, jnp.arange(L // Q_BLOCK))
    o = jnp.moveaxis(o, 0, 1).reshape(B, L, ATTN_DIM)
    y = o @ w_o
    if not with_ctx_out:
        return y, None
    s = jnp.einsum('bqhgd,bkhd->bhgqk', qc, kc, preferred_element_type=jnp.float32)
    s_snk = jnp.broadcast_to(sink, s.shape[:-1] + (1,))
    p = jax.nn.softmax(jnp.concatenate([s, s_snk], axis=-1), axis=-1)
    oc = jnp.einsum('bhgqk,bkhd->bqhgd', p[..., :Lc].astype(vc.dtype), vc).reshape(B, Lc, ATTN_DIM)
    return y, oc @ w_o


def swiglu(h, w_gate_up, w_down):
    gu = h @ w_gate_up
    return (jax.nn.silu(gu[..., :D_FF]) * gu[..., D_FF:]) @ w_down


def setup_inputs(seed: int = 0) -> dict:
    key = jax.random.key(seed)
    ks = jax.random.split(key, 17)
    nrm = jax.random.normal
    f32 = jnp.float32
    return {
        'x': nrm(ks[0], (BATCH, SEQ, D_MODEL), f32),
        'c': nrm(ks[1], (BATCH, D_MODEL), f32),
        'ctx': nrm(ks[2], (BATCH, CTX_LEN, D_MODEL), f32),
        'c_ctx': nrm(ks[3], (D_MODEL,), f32),
        'w_ada': nrm(ks[4], (DEPTH, D_MODEL, 6 * D_MODEL), f32) * (0.5 * D_MODEL ** -0.5),
        'b_ada': 0.02 * nrm(ks[5], (DEPTH, 6 * D_MODEL), f32),
        'norm_pre_mix': 1.0 + 0.05 * nrm(ks[6], (DEPTH, D_MODEL), f32),
        'norm_post_mix': 1.0 + 0.05 * nrm(ks[7], (DEPTH, D_MODEL), f32),
        'norm_pre_ffn': 1.0 + 0.05 * nrm(ks[8], (DEPTH, D_MODEL), f32),
        'norm_post_ffn': 1.0 + 0.05 * nrm(ks[9], (DEPTH, D_MODEL), f32),
        'w_pool': nrm(ks[10], (N_POOL_LAYERS, N_POOL_GROUPS, POOL_GROUP_DIM, POOL_GROUP_DIM), f32) * POOL_GROUP_DIM ** -0.5,
        'pool_scale': 1.0 + 0.05 * nrm(ks[11], (N_POOL_LAYERS, D_MODEL), f32),
        'w_qkv': nrm(ks[12], (N_ATTN_LAYERS, D_MODEL, ATTN_DIM + 2 * KV_DIM), f32) * D_MODEL ** -0.5,
        'w_o': nrm(ks[13], (N_ATTN_LAYERS, ATTN_DIM, D_MODEL), f32) * ATTN_DIM ** -0.5,
        'attn_sinks': 0.5 * nrm(ks[14], (N_ATTN_LAYERS, N_HEADS), f32),
        'w_gate_up': nrm(ks[15], (DEPTH, D_MODEL, 2 * D_FF), f32) * D_MODEL ** -0.5,
        'w_down': nrm(ks[16], (DEPTH, D_FF, D_MODEL), f32) * D_FF ** -0.5,
    }


def reference(x, c, ctx, c_ctx, w_ada, b_ada, norm_pre_mix, norm_post_mix, norm_pre_ffn, norm_post_ffn,
              w_pool, pool_scale, w_qkv, w_o, attn_sinks, w_gate_up, w_down):
    L = x.shape[1]
    cos, sin = axial_rope_tables(L)
    silu_c = jax.nn.silu(c)
    silu_cc = jax.nn.silu(c_ctx)
    for i in range(DEPTH):
        last = i == DEPTH - 1
        ada = silu_c @ w_ada[i] + b_ada[i]
        sh1, sc1, g1, sh2, sc2, g2 = jnp.split(ada[:, None, :], 6, axis=-1)
        ada_c = silu_cc @ w_ada[i] + b_ada[i]
        csh1, csc1, cg1, csh2, csc2, cg2 = jnp.split(ada_c, 6, axis=-1)

        h = modulate(rms_norm(x, norm_pre_mix[i]), sh1, sc1)
        hc = modulate(rms_norm(ctx, norm_pre_mix[i]), csh1, csc1)
        j = i // N_MIXERS
        if i % N_MIXERS == 0:
            y = multiscale_pool_mixer(h, w_pool[j], pool_scale[j])
            yc = None if last else multiscale_pool_mixer(hc, w_pool[j], pool_scale[j])
        else:
            y, yc = windowed_gqa_mixer(h, hc, w_qkv[j], w_o[j], attn_sinks[j], cos, sin, not last)
        x = x + g1 * rms_norm(y, norm_post_mix[i])
        if not last:
            ctx = ctx + cg1 * rms_norm(yc, norm_post_mix[i])

        h = modulate(rms_norm(x, norm_pre_ffn[i]), sh2, sc2)
        x = x + g2 * rms_norm(swiglu(h, w_gate_up[i], w_down[i]), norm_post_ffn[i])
        if not last:
            hc = modulate(rms_norm(ctx, norm_pre_ffn[i]), csh2, csc2)
            ctx = ctx + cg2 * rms_norm(swiglu(hc, w_gate_up[i], w_down[i]), norm_post_ffn[i])
    return x
```

```cpp
#include <hip/hip_runtime.h>
#include <cstdio>
#include <cstdint>

#ifndef WGM_GU
#define WGM_GU 8
#endif
#ifndef WGM_PL
#define WGM_PL 2
#endif
#ifndef WGM_QKV
#define WGM_QKV 8
#endif
#ifndef FILL_STOP
#define FILL_STOP 16u
#endif
#ifndef SWI_SP2
#define SWI_SP2 true
#endif
#ifndef SWI_ALIGN
#define SWI_ALIGN true
#endif

#define GAS __attribute__((address_space(1)))
#define LAS __attribute__((address_space(3)))
namespace pg8 {
#define PG8_LAS __attribute__((address_space(3)))
typedef unsigned short bf16_t;
typedef short bf16x8 __attribute__((ext_vector_type(8)));
typedef float f32x4 __attribute__((ext_vector_type(4)));
typedef float f32x2 __attribute__((ext_vector_type(2)));
typedef unsigned u32x4 __attribute__((ext_vector_type(4)));
typedef unsigned u32x2 __attribute__((ext_vector_type(2)));
typedef __bf16 bf16x2_t __attribute__((ext_vector_type(2)));
constexpr int BM = 256, BK = 64, HALF = 128, HTB = HALF * BK * 2  , STAGE_BYTES = 8 * HTB, NXCD = 8;

__host__ __device__ __forceinline__ int lds_byte(int r, int c) { const int st = (r >> 4) * 2 + (c >> 5), rr = r & 15, cc = c & 31, ob = rr * 64 + cc * 2; return st * 1024 + (ob ^ (((ob >> 9) & 1) << 5)); }
__host__ __device__ __forceinline__ void stage_rc(int b, int& R, int& C) { const int st = b / 1024, sb = b % 1024, swz = sb ^ (((sb >> 9) & 1) << 5); R = (st >> 1) * 16 + swz / 64; C = (st & 1) * 32 + (swz % 64) / 2; }
__host__ __device__ __forceinline__ int perm32(int rho) { const int n = rho >> 4, i = rho & 15; return 8 * (i >> 2) + 4 * n + (i & 3); }

struct Unit { int pm, pn; };
struct Gemm { const GAS bf16_t* A; const GAS bf16_t* Bt; int M, N, K, lda, ldb, agrp, agst; };

struct StaticOrder {
    static constexpr bool DYN = false;
    int nM, nN, nwg, G, c, WGM, rev;
    __host__ __device__ void init(int M, int N, int G_, int c_, int wgm = 4) { nM = M / BM; nN = N / BM; nwg = nM * nN; G = G_; c = c_; WGM = wgm; rev = 0; }
    __host__ __device__ bool next(int i, Unit& u) const {
        const long L = (long)i * G + c; if (L >= nwg) return false;
        int wgid = (int)L; { const int q = nwg / NXCD, r = nwg % NXCD, xcd = wgid % NXCD, cnt = xcd < r ? q + 1 : q; int off = wgid / NXCD; if (rev) off = cnt - 1 - off;
            wgid = (xcd < r ? xcd * (q + 1) : r * (q + 1) + (xcd - r) * q) + off; }
        const int nig = WGM * nN, gid = wgid / nig, fm = gid * WGM, gsz = (nM - fm) < WGM ? (nM - fm) : WGM;
        u.pm = fm + ((wgid % nig) % gsz); u.pn = (wgid % nig) / gsz; return true;
    }
};

struct DynOrder {
    static constexpr bool DYN = true;
    int nM, nN, nwg, G, c, WGM; GAS unsigned* heads; PG8_LAS volatile int* slot;
    __device__ void init(int M, int N, int G_, int c_, int wgm, GAS unsigned* h, PG8_LAS volatile int* sl) { nM = M / BM; nN = N / BM; nwg = nM * nN; G = G_; c = c_; WGM = wgm; heads = h; slot = sl; }
    __device__ void chunk(int x, int& base, int& cnt) const { const int q = nwg / NXCD, r = nwg % NXCD; cnt = x < r ? q + 1 : q; base = x < r ? x * (q + 1) : r * (q + 1) + (x - r) * q; }
    __device__ int dealt(int x) const { return (2 * G - x + NXCD - 1) / NXCD; }
    __device__ void map(int wgid, Unit& u) const {
        const int nig = WGM * nN, gid = wgid / nig, fm = gid * WGM, gsz = (nM - fm) < WGM ? (nM - fm) : WGM;
        u.pm = fm + ((wgid % nig) % gsz); u.pn = (wgid % nig) / gsz; }
    __device__ bool next(int i, Unit& u) const {
        const long L = (long)i * G + c; if (L >= nwg) return false;
        int base, cnt; chunk((int)(L % NXCD), base, cnt); map(base + (int)(L / NXCD), u); return true; }
    __device__ unsigned issue(int tid, int hq) const {
        unsigned v = 0u;
        if (tid < NXCD) v = __hip_atomic_fetch_add(heads + ((hq + tid) & (NXCD - 1)) * 64, tid == 0 ? 1u : 0u, __ATOMIC_RELAXED, __HIP_MEMORY_SCOPE_AGENT);
        return v; }
    __device__ bool resolve(int tid, unsigned pend, int& hq, Unit& u) const {
        if (tid < 64) {
            int w = -1, qs = hq;
#pragma unroll 1
            for (int k = 0; k < NXCD; ++k) {
                const int q = (hq + k) & (NXCD - 1); int base, cnt; chunk(q, base, cnt);
                unsigned t = (unsigned)__builtin_amdgcn_readlane((int)pend, k);
                int off = dealt(q) + (int)t;
                if (off >= cnt) continue;
                if (k > 0) { unsigned tt = 0u; if (tid == 0) tt = __hip_atomic_fetch_add(heads + q * 64, 1u, __ATOMIC_RELAXED, __HIP_MEMORY_SCOPE_AGENT);
                    t = (unsigned)__builtin_amdgcn_readfirstlane((int)tt); off = dealt(q) + (int)t; if (off >= cnt) continue; }
                w = base + off; qs = q; break;
            }
            if (tid == 0) { slot[0] = w; slot[1] = qs; }
        }
        asm volatile("s_waitcnt lgkmcnt(0)" ::: "memory"); __builtin_amdgcn_s_barrier();
        const int w = __builtin_amdgcn_readfirstlane(slot[0]); hq = __builtin_amdgcn_readfirstlane(slot[1]);
        if (w < 0) return false;
        map(w, u); return true; }
};

__device__ __forceinline__ unsigned cvtpk(float lo, float hi) { f32x2 v = {lo, hi}; bf16x2_t b = __builtin_convertvector(v, bf16x2_t); return __builtin_bit_cast(unsigned, b); }


struct EpiPlain {
    static constexpr bool PERM = true;
    GAS bf16_t* O; int ldc; const GAS float* cscale;
    __device__ __forceinline__ void operator()(const f32x4 (&acc)[2][2][4][2], const Unit& u, int wr, int wc, int fr, int fq) const {
        const int row0 = u.pm * BM + wr * 64 + fr, col0 = u.pn * BM + wc * 32 + 8 * fq;
        f32x4 sv[2][2];
#pragma unroll
        for (int bj = 0; bj < 2; ++bj)
#pragma unroll
            for (int n = 0; n < 2; ++n) sv[bj][n] = cscale ? *(const GAS f32x4*)(cscale + col0 + bj * HALF + 4 * n) : (f32x4){1.f, 1.f, 1.f, 1.f};
#pragma unroll
        for (int ai = 0; ai < 2; ++ai)
#pragma unroll
            for (int m = 0; m < 4; ++m) { GAS bf16_t* rowp = O + (size_t)(row0 + ai * HALF + m * 16) * ldc + col0;
#pragma unroll
                for (int bj = 0; bj < 2; ++bj) { const f32x4 v0 = acc[ai][bj][m][0] * sv[bj][0], v1 = acc[ai][bj][m][1] * sv[bj][1];
                    u32x4 w; w.x = cvtpk(v0[0], v0[1]); w.y = cvtpk(v0[2], v0[3]); w.z = cvtpk(v1[0], v1[1]); w.w = cvtpk(v1[2], v1[3]);
                    *(GAS u32x4*)(rowp + bj * HALF) = w; } }
    }
};
__device__ __forceinline__ float silu_mul(float g, float u) { return g * u * __builtin_amdgcn_rcpf(1.0f + __builtin_amdgcn_exp2f(-1.4426950408889634f * g)); }
struct EpiSwiGLU {
    static constexpr bool PERM = true;
    GAS bf16_t* O; int ldc;
    __device__ __forceinline__ void operator()(const f32x4 (&acc)[2][2][4][2], const Unit& u, int wr, int wc, int fr, int fq) const {
        const int row0 = u.pm * BM + wr * 64 + fr, col0 = u.pn * HALF + wc * 32 + 8 * fq;
#pragma unroll
        for (int ai = 0; ai < 2; ++ai)
#pragma unroll
            for (int m = 0; m < 4; ++m) { GAS bf16_t* rowp = O + (size_t)(row0 + ai * HALF + m * 16) * ldc + col0;
                const f32x4 g0 = acc[ai][0][m][0], g1 = acc[ai][0][m][1], u0 = acc[ai][1][m][0], u1 = acc[ai][1][m][1];
                u32x4 w; w.x = cvtpk(silu_mul(g0[0], u0[0]), silu_mul(g0[1], u0[1])); w.y = cvtpk(silu_mul(g0[2], u0[2]), silu_mul(g0[3], u0[3]));
                w.z = cvtpk(silu_mul(g1[0], u1[0]), silu_mul(g1[1], u1[1])); w.w = cvtpk(silu_mul(g1[2], u1[2]), silu_mul(g1[3], u1[3]));
                __builtin_nontemporal_store(w, (GAS u32x4*)rowp); }
    }
};
struct EpiQKV {
    static constexpr bool PERM = false;
    GAS bf16_t* Q; GAS bf16_t* Kb; GAS bf16_t* Vb; const GAS float* tab; int nlat, vld;
    __device__ __forceinline__ void operator()(const f32x4 (&acc)[2][2][4][2], const Unit& u, int wr, int wc, int fr, int fq) const {
        const int row0 = u.pm * BM + wr * 64 + fr;
        if (u.pn == 9) {
#pragma unroll
            for (int ai = 0; ai < 2; ++ai)
#pragma unroll
                for (int m = 0; m < 4; ++m) { const int row = row0 + ai * HALF + m * 16;
#pragma unroll
                    for (int bj = 0; bj < 2; ++bj)
#pragma unroll
                        for (int n = 0; n < 2; ++n) { const f32x4 v = acc[ai][bj][m][n]; const unsigned w0 = cvtpk(v[0], v[1]), w1 = cvtpk(v[2], v[3]);
                            GAS bf16_t* p = Vb + ((size_t)((2 * bj + (wc >> 1)) * vld + (row >> 6)) * 64 + (32 * (wc & 1) + 16 * n + 4 * fq)) * 64 + (row & 63);
                            p[0] = (bf16_t)(w0 & 0xffffu); p[64] = (bf16_t)(w0 >> 16); p[128] = (bf16_t)(w1 & 0xffffu); p[192] = (bf16_t)(w1 >> 16); } }
            return;
        }
        const bool isq = u.pn < 8; const float sc = isq ? 0.125f * 1.4426950408889634f : 1.0f;   const bool lat = u.pm * BM < nlat;
        GAS bf16_t* base = isq ? Q + (size_t)u.pn * BM : Kb; const int ldc = isq ? 2048 : 256; const int col0 = wc * 32 + 8 * fq;
#pragma unroll
        for (int ai = 0; ai < 2; ++ai)
#pragma unroll
            for (int m = 0; m < 4; ++m) { const int row = row0 + ai * HALF + m * 16; GAS bf16_t* rowp = base + (size_t)row * ldc + col0;
                f32x4 cs0 = {1.f, 0.f, 1.f, 0.f}, cs1 = {1.f, 0.f, 1.f, 0.f};
                if (lat) { const int t = row & 2047, pos = (wc & 1) ? (t & 63) : (t >> 6); const GAS f32x4* tp = (const GAS f32x4*)(tab + (size_t)(pos * 16 + 4 * fq) * 2); cs0 = tp[0]; cs1 = tp[1]; }
#pragma unroll
                for (int bj = 0; bj < 2; ++bj) { const f32x4 x1 = acc[ai][bj][m][0] * sc, x2 = acc[ai][bj][m][1] * sc;
                    const float a0 = x1[0] * cs0[0] - x2[0] * cs0[1], a1 = x1[1] * cs0[2] - x2[1] * cs0[3], a2 = x1[2] * cs1[0] - x2[2] * cs1[1], a3 = x1[3] * cs1[2] - x2[3] * cs1[3];
                    const float b0 = x2[0] * cs0[0] + x1[0] * cs0[1], b1 = x2[1] * cs0[2] + x1[1] * cs0[3], b2 = x2[2] * cs1[0] + x1[2] * cs1[1], b3 = x2[3] * cs1[2] + x1[3] * cs1[3];
                    u32x4 w; w.x = cvtpk(a0, a1); w.y = cvtpk(a2, a3); w.z = cvtpk(b0, b1); w.w = cvtpk(b2, b3);
                    *(GAS u32x4*)(rowp + bj * HALF) = w; } }
    }
};

template <class Epi, class Sched, bool ALIGN_EPI = true, bool SP2 = true>
__device__ __forceinline__ void gemm_phase(PG8_LAS unsigned char* lds, const int tid, const Gemm g, const Sched& S, const Epi& E) {
    const int wid = __builtin_amdgcn_readfirstlane(tid >> 6), lane = tid & 63, wr = wid >> 2, wc = wid & 3, fr = lane & 15, fq = lane >> 4;
    const int K = g.K, nt = K / BK;
    unsigned voffA[2], voffB[2];
#pragma unroll
    for (int i = 0; i < 2; ++i) { int R, C; stage_rc(tid * 16 + i * 8192, R, C); const int Rb = Epi::PERM ? ((R & ~31) + perm32(R & 31)) : R;
        voffA[i] = (unsigned)(R * g.lda + C) * 2u; voffB[i] = (unsigned)(Rb * g.ldb + C) * 2u; }
    const size_t kstep = (size_t)(BK * 2);
    const size_t hstepA = (size_t)HALF * g.lda * 2, hstepB = (size_t)HALF * g.ldb * 2;
    const size_t tstepA = 2 * hstepA, tstepB = 2 * hstepB;
    const unsigned ldsw = (unsigned)wid * 1024u;
    const int aoff = lds_byte(wr * 64 + fr, fq * 8), boff = lds_byte(wc * 32 + fr, fq * 8);
#define PG8_SA(b, h) (((b) * 2 + (h)) * HTB)
#define PG8_SB(b, h) ((4 + (b) * 2 + (h)) * HTB)
#define PG8_STAGE(bufoff, gbase, voff) do { _Pragma("unroll") for (int _i = 0; _i < 2; ++_i) \
        __builtin_amdgcn_global_load_lds((const GAS unsigned*)((const GAS char*)(gbase) + (voff)[_i]), (PG8_LAS unsigned*)(lds + (bufoff) + ldsw + _i * 8192), 16, 0, 0); } while (0)
#define PG8_LDA(dst, b, h) do { _Pragma("unroll") for (int m = 0; m < 4; ++m) _Pragma("unroll") for (int k = 0; k < 2; ++k) dst[m][k] = *(const PG8_LAS bf16x8*)(lds + PG8_SA(b, h) + aoff + m * 2048 + k * 1024); } while (0)
#define PG8_LDB(dst, b, h) do { _Pragma("unroll") for (int n = 0; n < 2; ++n) _Pragma("unroll") for (int k = 0; k < 2; ++k) dst[n][k] = *(const PG8_LAS bf16x8*)(lds + PG8_SB(b, h) + boff + n * 2048 + k * 1024); } while (0)
#define PG8_MMA(ai, bj, At, Bt) do { __builtin_amdgcn_s_setprio(1); _Pragma("unroll") for (int m = 0; m < 4; ++m) _Pragma("unroll") for (int n = 0; n < 2; ++n) _Pragma("unroll") for (int k = 0; k < 2; ++k) \
        acc[ai][bj][m][n] = __builtin_amdgcn_mfma_f32_16x16x32_bf16(Bt[n][k], At[m][k], acc[ai][bj][m][n], 0, 0, 0); __builtin_amdgcn_s_setprio(0); } while (0)
#define PG8_WAIT_V(n) asm volatile("s_waitcnt vmcnt(" #n ")" ::: "memory")
#define PG8_WAIT_L(n) asm volatile("s_waitcnt lgkmcnt(" #n ")" ::: "memory")
#define PG8_BAR __builtin_amdgcn_s_barrier()
#define PG8_SCHED __builtin_amdgcn_sched_barrier(0)
#define PG8_ABASE(u) ((const GAS char*)g.A + (size_t)(u).pm * tstepA + (g.agrp ? (size_t)((u).pn / g.agrp) * (size_t)g.agst * 2 : (size_t)0))
    Unit cur, nxt; int ui = 0;
    if (!S.next(0, cur)) return;
    __builtin_amdgcn_s_waitcnt(0);
    f32x4 acc[2][2][4][2];
#pragma unroll
    for (int a = 0; a < 2; ++a)
#pragma unroll
        for (int b = 0; b < 2; ++b)
#pragma unroll
            for (int m = 0; m < 4; ++m)
#pragma unroll
                for (int n = 0; n < 2; ++n) acc[a][b][m][n] = (f32x4){0.f, 0.f, 0.f, 0.f};
    bf16x8 At[4][2], B0[2][2], B1[2][2];
    const GAS char* cA = PG8_ABASE(cur); const GAS char* cB = (const GAS char*)g.Bt + (size_t)cur.pn * tstepB;
    if constexpr (SP2) {
        PG8_STAGE(PG8_SB(0, 0), cB, voffB); PG8_STAGE(PG8_SB(0, 1), cB + hstepB, voffB); PG8_STAGE(PG8_SA(0, 0), cA, voffA); PG8_STAGE(PG8_SA(0, 1), cA + hstepA, voffA);
        if (wr == 1) PG8_BAR;
        PG8_WAIT_V(2); PG8_BAR;
        PG8_STAGE(PG8_SB(1, 0), cB + kstep, voffB); PG8_STAGE(PG8_SA(1, 0), cA + kstep, voffA); PG8_STAGE(PG8_SB(1, 1), cB + hstepB + kstep, voffB);
        PG8_WAIT_V(6); PG8_BAR;
    } else {
        PG8_STAGE(PG8_SB(0, 0), cB, voffB); PG8_STAGE(PG8_SA(0, 0), cA, voffA); PG8_STAGE(PG8_SB(0, 1), cB + hstepB, voffB); PG8_STAGE(PG8_SA(0, 1), cA + hstepA, voffA);
        if (wr == 1) PG8_BAR;
        PG8_WAIT_V(4); PG8_BAR;
        PG8_STAGE(PG8_SB(1, 0), cB + kstep, voffB); PG8_STAGE(PG8_SA(1, 0), cA + kstep, voffA); PG8_STAGE(PG8_SB(1, 1), cB + hstepB + kstep, voffB);
        PG8_WAIT_V(6); PG8_BAR;
    }
    bool has_next = false; int hq = 0; unsigned pend = 0u; Unit nn;
    if constexpr (Sched::DYN) { has_next = S.next(1, nxt); hq = (int)(__builtin_amdgcn_s_getreg((3 << 11) | 20) & (NXCD - 1)); }
    for (;;) {
        if constexpr (!Sched::DYN) has_next = S.next(ui + 1, nxt);
        const GAS char* nA = has_next ? PG8_ABASE(nxt) : cA; const GAS char* nB = has_next ? (const GAS char*)g.Bt + (size_t)nxt.pn * tstepB : cB;
        for (int t = 0; t < nt; t += 2) {
            const bool last = (t == nt - 2);
            const GAS char* a1 = cA + (size_t)(t + 1) * kstep;
            const GAS char* a2 = last ? nA : cA + (size_t)(t + 2) * kstep; const GAS char* b2 = last ? nB : cB + (size_t)(t + 2) * kstep;
            const GAS char* a3 = a2 + kstep; const GAS char* b3 = b2 + kstep;
            if constexpr (SP2) {
            PG8_LDB(B0, 0, 0); PG8_LDB(B1, 0, 1); PG8_SCHED; PG8_LDA(At, 0, 0); PG8_STAGE(PG8_SA(1, 1), a1 + hstepA, voffA);
            PG8_WAIT_V(8); PG8_WAIT_L(0); PG8_BAR; PG8_MMA(0, 0, At, B0); PG8_MMA(0, 1, At, B1); PG8_BAR; PG8_SCHED;
            PG8_LDA(At, 0, 1); PG8_STAGE(PG8_SB(0, 0), b2, voffB); PG8_STAGE(PG8_SB(0, 1), b2 + hstepB, voffB); PG8_STAGE(PG8_SA(0, 0), a2, voffA);
            PG8_WAIT_V(8); PG8_WAIT_L(0); PG8_BAR; PG8_MMA(1, 0, At, B0); PG8_MMA(1, 1, At, B1); PG8_BAR; PG8_SCHED;
            PG8_LDB(B0, 1, 0); PG8_LDB(B1, 1, 1); PG8_SCHED; PG8_LDA(At, 1, 0); PG8_STAGE(PG8_SA(0, 1), a2 + hstepA, voffA);
            PG8_WAIT_V(8); PG8_WAIT_L(0); PG8_BAR; PG8_MMA(0, 0, At, B0); PG8_MMA(0, 1, At, B1); PG8_BAR; PG8_SCHED;
            PG8_LDA(At, 1, 1); PG8_STAGE(PG8_SB(1, 0), b3, voffB); PG8_STAGE(PG8_SB(1, 1), b3 + hstepB, voffB); PG8_STAGE(PG8_SA(1, 0), a3, voffA);
            PG8_WAIT_V(8); PG8_WAIT_L(0); PG8_BAR; PG8_MMA(1, 0, At, B0); PG8_MMA(1, 1, At, B1); PG8_BAR; PG8_SCHED;
                    } else {
            PG8_LDB(B0, 0, 0); PG8_SCHED; PG8_LDA(At, 0, 0); PG8_STAGE(PG8_SA(1, 1), a1 + hstepA, voffA);
            PG8_WAIT_L(8); PG8_BAR; PG8_WAIT_L(0); PG8_MMA(0, 0, At, B0); PG8_BAR; PG8_SCHED;
            PG8_LDB(B1, 0, 1); PG8_STAGE(PG8_SB(0, 0), b2, voffB);
            PG8_BAR; PG8_WAIT_L(0); PG8_MMA(0, 1, At, B1); PG8_BAR;
            PG8_LDA(At, 0, 1); PG8_STAGE(PG8_SA(0, 0), a2, voffA);
            PG8_BAR; PG8_WAIT_L(0); PG8_MMA(1, 0, At, B0); PG8_BAR; PG8_SCHED;
            PG8_STAGE(PG8_SB(0, 1), b2 + hstepB, voffB);
            PG8_WAIT_V(6); PG8_BAR; PG8_MMA(1, 1, At, B1); PG8_BAR;
            PG8_LDB(B0, 1, 0); PG8_SCHED; PG8_LDA(At, 1, 0); PG8_STAGE(PG8_SA(0, 1), a2 + hstepA, voffA);
            PG8_WAIT_L(8); PG8_BAR; PG8_WAIT_L(0); PG8_MMA(0, 0, At, B0); PG8_BAR; PG8_SCHED;
            PG8_LDB(B1, 1, 1); PG8_STAGE(PG8_SB(1, 0), b3, voffB);
            PG8_BAR; PG8_WAIT_L(0); PG8_MMA(0, 1, At, B1); PG8_BAR;
            PG8_LDA(At, 1, 1); PG8_STAGE(PG8_SA(1, 0), a3, voffA);
            PG8_BAR; PG8_WAIT_L(0); PG8_MMA(1, 0, At, B0); PG8_BAR; PG8_SCHED;
            PG8_STAGE(PG8_SB(1, 1), b3 + hstepB, voffB);
            PG8_WAIT_V(6); PG8_BAR; PG8_MMA(1, 1, At, B1); PG8_BAR;
            }
        }
        if constexpr (ALIGN_EPI) { if (wr == 0) PG8_BAR; }
        if constexpr (Sched::DYN) { if (has_next) pend = S.issue(tid, hq); }
        E(acc, cur, wr, wc, fr, fq);
        if (!has_next) break;
        bool has_nn = false;
        if constexpr (Sched::DYN) has_nn = S.resolve(tid, pend, hq, nn);
#pragma unroll
        for (int a = 0; a < 2; ++a)
#pragma unroll
            for (int b = 0; b < 2; ++b)
#pragma unroll
                for (int m = 0; m < 4; ++m)
#pragma unroll
                    for (int n = 0; n < 2; ++n) acc[a][b][m][n] = (f32x4){0.f, 0.f, 0.f, 0.f};
        cur = nxt; cA = nA; cB = nB; ++ui;
        if constexpr (Sched::DYN) { nxt = nn; has_next = has_nn; }
        if constexpr (ALIGN_EPI) { if (wr == 1) PG8_BAR; }
    }
    PG8_WAIT_V(0);
    if constexpr (!ALIGN_EPI) { if (wr == 0) PG8_BAR; }
    PG8_BAR;
#undef PG8_ABASE
#undef PG8_SA
#undef PG8_SB
#undef PG8_STAGE
#undef PG8_LDA
#undef PG8_LDB
#undef PG8_MMA
#undef PG8_WAIT_V
#undef PG8_WAIT_L
#undef PG8_BAR
#undef PG8_SCHED
}
}

constexpr int NWAVES = 8;
constexpr int D = 2048, NB = 16, SEQ = 2048, CTXL = 256, DEPTH = 4, DFF = 5632, NGU = 2 * DFF, NQKV = 2560, KVD = 256, HD = 64, NHEAD = 32, NKVH = 4;
constexpr int ML = NB * SEQ, MC = NB * CTXL, MT = ML + MC;
constexpr int NADA = 6 * D;
constexpr float RMS_EPS = 1e-6f;

constexpr size_t MiB = 1u << 20;
constexpr size_t WS_CTL = 0, CTL_ZERO_BYTES = 1 * MiB;
constexpr size_t WS_ADA = 1 * MiB;
constexpr size_t WS_ROPE = 5 * MiB;
constexpr size_t WS_Y2 = 6 * MiB;
constexpr size_t WS_XB = 1026 * MiB;
constexpr size_t WS_H = 38 * MiB;
constexpr size_t WS_Y = 182 * MiB;
constexpr size_t WS_ACT = 326 * MiB;
constexpr size_t WS_Q = 326 * MiB, WS_K = 470 * MiB, WS_V = 488 * MiB, WS_O = 506 * MiB, WS_P = 326 * MiB;
constexpr size_t WS_WGU = 722 * MiB, WS_WD = 898 * MiB, WS_WQKV = 986 * MiB, WS_WO = 1006 * MiB, WS_WP = 1022 * MiB, WS_END = 1170 * MiB;
static_assert(WS_ACT + (size_t)MT * DFF * 2 <= WS_WGU && WS_O + (size_t)MT * D * 2 <= WS_WGU && WS_Y + (size_t)MT * D * 2 <= WS_ACT && WS_H + (size_t)MT * D * 2 <= WS_Y, "d_ws map");
static_assert(WS_WGU + (size_t)DEPTH * NGU * D * 2 <= WS_WD && WS_WD + (size_t)DEPTH * D * DFF * 2 <= WS_WQKV && WS_WQKV + (size_t)2 * NQKV * D * 2 <= WS_WO && WS_WO + (size_t)2 * D * D * 2 <= WS_WP && WS_WP + (size_t)2 * D * 512 * 2 <= WS_XB && WS_XB + (size_t)MT * D * 2 <= WS_END, "d_ws weights");
constexpr int CW_BAR = 4096;
constexpr int CW_ADA0 = 32768 + 2048;
constexpr int CW_FA = 32768 + 1024;
constexpr int CW_FQ = 32768;
constexpr int CW_DQ = 65536;

constexpr int LDS_BYTES = 147456;
constexpr int LDSCTL_OFF = LDS_BYTES - 512;
constexpr int MISC_OFF = LDSCTL_OFF + 64;

typedef unsigned short bf16;
typedef unsigned v4u __attribute__((ext_vector_type(4)));
typedef unsigned v2u __attribute__((ext_vector_type(2)));
typedef float f32x4 __attribute__((ext_vector_type(4)));
typedef float f32x16 __attribute__((ext_vector_type(16)));
typedef short bf16x8 __attribute__((ext_vector_type(8)));
typedef short s16x4 __attribute__((ext_vector_type(4)));
typedef GAS unsigned gu32;
typedef GAS float gf32; typedef const GAS float cgf32; typedef GAS bf16 gb16; typedef const GAS bf16 cgb16;
#define RLX_AGENT __ATOMIC_RELAXED, __HIP_MEMORY_SCOPE_AGENT
#define LDS_WAIT() asm volatile("s_waitcnt lgkmcnt(0)" ::: "memory")
using pg8::cvtpk;

#define XB_TMO      128
#define XB_XCNT(j)  (256  + 64 * (j))
#define XB_XSUB(j)  (1280 + 64 * (j))
#define XB_XGEN(j)  (2304 + 64 * (j))
#define XB_TOP      3328
#define XB_TOPGEN   3392
#define XCD_BAR_WORDS 3456
#define XB_SPIN_CAP (1u << 18)

__device__ __forceinline__ unsigned xb_ld(unsigned* p)              { return __hip_atomic_load(p, __ATOMIC_RELAXED, __HIP_MEMORY_SCOPE_AGENT); }
__device__ __forceinline__ unsigned xb_add(unsigned* p, unsigned v) { return __hip_atomic_fetch_add(p, v, __ATOMIC_RELAXED, __HIP_MEMORY_SCOPE_AGENT); }
__device__ __forceinline__ unsigned xb_xcc_id() { return (unsigned)__builtin_amdgcn_s_getreg((3 << 11) | 20) & 0xFu; }
#define XB_SPIN(cond, bar) do { unsigned _sp = 0; while (cond) { __builtin_amdgcn_s_sleep(1); \
    if ((++_sp & 255u) == 0u) { if (xb_ld(&(bar)[XB_TMO])) break; if (_sp > XB_SPIN_CAP) { atomicAdd(&(bar)[XB_TMO], 1u); break; } } } } while (0)

struct XcdBarrier { unsigned* bar; unsigned x; volatile LAS unsigned* st; };

__device__ __forceinline__ XcdBarrier xcd_barrier_post(unsigned* bar, volatile LAS unsigned* st) {
    XcdBarrier b; b.bar = bar; b.x = xb_xcc_id(); b.st = st;
    if (threadIdx.x == 0) (void)xb_add(&bar[XB_XCNT(b.x)], 1u);
    return b;
}
__device__ __forceinline__ void xcd_barrier_complete(unsigned* bar, unsigned x, unsigned& nloc, unsigned& nx) {
    const unsigned G = gridDim.x * gridDim.y * gridDim.z;
    unsigned sum, cnt, mine, sp = 0u;
    for (;;) {
        sum = 0u; cnt = 0u; mine = 0u;
#pragma unroll
        for (unsigned j = 0; j < 16; ++j) { const unsigned c = xb_ld(&bar[XB_XCNT(j)]); sum += c; cnt += (c > 0u) ? 1u : 0u; mine = (j == x) ? c : mine; }
        if (sum == G) break;
        __builtin_amdgcn_s_sleep(1);
        if ((++sp & 255u) == 0u) { if (xb_ld(&bar[XB_TMO])) break; if (sp > XB_SPIN_CAP) { atomicAdd(&bar[XB_TMO], 1u); break; } }
    }
    nloc = mine > 0u ? mine : 1u; nx = cnt > 0u ? cnt : 1u;
}
__device__ __forceinline__ void xcd_barrier(const XcdBarrier& b) {
    asm volatile("s_waitcnt vmcnt(0)" ::: "memory");
    __syncthreads();
    if (threadIdx.x == 0) {
        unsigned* bar = b.bar;
        __builtin_amdgcn_s_waitcnt(0);
        unsigned nloc = b.st[0], nx = b.st[1];
        if (nloc == 0u) { xcd_barrier_complete(bar, b.x, nloc, nx); b.st[0] = nloc; b.st[1] = nx; }
        const unsigned old = xb_add(&bar[XB_XSUB(b.x)], 1u);
        const unsigned gen = old / nloc;
        if (old + 1u == (gen + 1u) * nloc) {
            __builtin_amdgcn_fence(__ATOMIC_RELEASE, "agent");
            asm volatile("s_waitcnt vmcnt(0)" ::: "memory");
            const unsigned og = xb_add(&bar[XB_TOP], 1u);
            const unsigned tg = og / nx;
            if (og + 1u == (tg + 1u) * nx) xb_add(&bar[XB_TOPGEN], 1u);
            else XB_SPIN(xb_ld(&bar[XB_TOPGEN]) == tg, bar);
            __builtin_amdgcn_fence(__ATOMIC_ACQUIRE, "agent");
            xb_add(&bar[XB_XGEN(b.x)], 1u);
            asm volatile("s_waitcnt vmcnt(0)" ::: "memory");
        } else {
            XB_SPIN(xb_ld(&bar[XB_XGEN(b.x)]) == gen, bar);
            __builtin_amdgcn_fence(__ATOMIC_ACQUIRE, "agent");
            asm volatile("s_waitcnt vmcnt(0)" ::: "memory");
        }
    }
    __syncthreads();
}

struct Args { const float* in[17]; float* out; unsigned char* ws; int ph_lo, ph_hi; };
#define GIN(k) ((cgf32*)args.in[k])
struct Frame {
    LAS unsigned char* lds;
    volatile LAS unsigned* MISC;
    gu32* ctl;
    int tid, lane, wave, vcu, G, bx;
    GAS unsigned char* ws;
};

__device__ __forceinline__ float wave_sum(float v) {
#define WS_DPP(ctrl) v += __int_as_float(__builtin_amdgcn_update_dpp(0, __float_as_int(v), (ctrl), 0xF, 0xF, true))
    WS_DPP(0xB1); WS_DPP(0x4E); WS_DPP(0x141); WS_DPP(0x140);
#undef WS_DPP
    const float a = __int_as_float(__builtin_amdgcn_readlane(__float_as_int(v), 0)), b = __int_as_float(__builtin_amdgcn_readlane(__float_as_int(v), 16));
    const float c = __int_as_float(__builtin_amdgcn_readlane(__float_as_int(v), 32)), d = __int_as_float(__builtin_amdgcn_readlane(__float_as_int(v), 48));
    return (a + b) + (c + d);
}

__device__ __forceinline__ void p0_transpose_item(cgf32* W, int ldw, gb16* WT, int ldk, int k0, int n0, int drow0, LAS float* scr, int lane) {
    f32x4 v[16];
#pragma unroll
    for (int i = 0; i < 16; ++i) v[i] = __builtin_nontemporal_load((const GAS f32x4*)(W + (size_t)(k0 + 4 * i + (lane >> 4)) * ldw + n0 + 4 * (lane & 15)));
#pragma unroll
    for (int i = 0; i < 16; ++i) { LAS float* d = scr + (4 * i + (lane >> 4)) * 65 + 4 * (lane & 15); d[0] = v[i].x; d[1] = v[i].y; d[2] = v[i].z; d[3] = v[i].w; }
    LDS_WAIT(); asm volatile("" ::: "memory");
    const int c = lane & 7;
#pragma unroll
    for (int j = 0; j < 8; ++j) { const int n = (lane >> 3) + 8 * j; const LAS float* s = scr + (8 * c) * 65 + n;
        v4u o; o.x = cvtpk(s[0 * 65], s[1 * 65]); o.y = cvtpk(s[2 * 65], s[3 * 65]); o.z = cvtpk(s[4 * 65], s[5 * 65]); o.w = cvtpk(s[6 * 65], s[7 * 65]);
        __builtin_nontemporal_store(o, (GAS v4u*)(WT + (size_t)(drow0 + n) * ldk + k0 + 8 * c)); }
    LDS_WAIT(); asm volatile("" ::: "memory");
}

constexpr int I_GU = (D / 64) * (NGU / 64), I_D = (DFF / 64) * (D / 64), I_QKV = (D / 64) * (NQKV / 64), I_O = (D / 64) * (D / 64), I_P = (512 / 64) * (512 / 64);
__device__ __forceinline__ int conv_count(int l) { return I_GU + I_D + ((l & 1) ? I_QKV + I_O : 4 * I_P); }
__device__ __forceinline__ void conv_layer_item(const Args& args, GAS unsigned char* ws, int l, int r, LAS float* scr, int lane) {
    if (r < I_GU) { const int q = r, nblk = NGU / 64, k0 = 64 * (q / nblk), n0 = 64 * (q % nblk);
        const int nn = n0 < DFF ? n0 : n0 - DFF, drow = (nn >> 7) * 256 + (n0 < DFF ? 0 : 128) + (nn & 127);
        p0_transpose_item(GIN(15) + (size_t)l * D * NGU, NGU, (gb16*)(ws + WS_WGU) + (size_t)l * NGU * D, D, k0, n0, drow, scr, lane); return; } r -= I_GU;
    if (r < I_D) { const int q = r, nblk = D / 64, k0 = 64 * (q / nblk), n0 = 64 * (q % nblk);
        p0_transpose_item(GIN(16) + (size_t)l * DFF * D, D, (gb16*)(ws + WS_WD) + (size_t)l * D * DFF, DFF, k0, n0, n0, scr, lane); return; } r -= I_D;
    const int j = l >> 1;
    if (l & 1) {
        if (r < I_QKV) { const int q = r, nblk = NQKV / 64, k0 = 64 * (q / nblk), n0 = 64 * (q % nblk);
            p0_transpose_item(GIN(12) + (size_t)j * D * NQKV, NQKV, (gb16*)(ws + WS_WQKV) + (size_t)j * NQKV * D, D, k0, n0, n0, scr, lane); return; } r -= I_QKV;
        { const int q = r, nblk = D / 64, k0 = 64 * (q / nblk), n0 = 64 * (q % nblk);
            p0_transpose_item(GIN(13) + (size_t)j * D * D, D, (gb16*)(ws + WS_WO) + (size_t)j * D * D, D, k0, n0, n0, scr, lane); }
    } else { const int jg = 4 * j + r / I_P, q = r % I_P, nblk = 512 / 64, k0 = 64 * (q / nblk), n0 = 64 * (q % nblk);
        p0_transpose_item(GIN(10) + (size_t)jg * 512 * 512, 512, (gb16*)(ws + WS_WP) + (size_t)jg * 512 * 512, 512, k0, n0, n0, scr, lane); }
}
__device__ __forceinline__ bool conv_batch(const Args& args, GAS unsigned char* ws, LAS unsigned char* lds, int l, int batch, int tid) {
    const int wave = __builtin_amdgcn_readfirstlane(tid >> 6), r = batch * NWAVES + wave;
    if (r < conv_count(l)) conv_layer_item(args, ws, l, r, (LAS float*)(lds + wave * 16896), tid & 63);
    return true;
}
__device__ __forceinline__ void conv_drain(const Args& args, GAS unsigned char* ws, LAS unsigned char* lds, int l, int tid) {
    volatile LAS int* st = (volatile LAS int*)(lds + MISC_OFF) + 40;
    const int nb = (conv_count(l) + NWAVES - 1) / NWAVES;
    GAS unsigned* q = (GAS unsigned*)(ws + WS_CTL) + CW_FQ + 64 * l;
    unsigned nxt = 0u;
    if (tid == 0) nxt = __hip_atomic_fetch_add(q, 1u, RLX_AGENT);
    for (;;) {
        __syncthreads();
        if (tid == 0) st[0] = (int)nxt;
        __syncthreads();
        const int b = __builtin_amdgcn_readfirstlane(st[0]);
        if (b >= nb) break;
        if (tid == 0) nxt = __hip_atomic_fetch_add(q, 1u, RLX_AGENT);
        conv_batch(args, ws, lds, l, b, tid);
    }
    __syncthreads();
}
__device__ __forceinline__ void xcd_barrier_fill(const XcdBarrier& b, const Args& args, GAS unsigned char* ws, LAS unsigned char* lds, int fl, int nf, int tid) {
    volatile LAS int* st = (volatile LAS int*)(lds + MISC_OFF) + 40;
    asm volatile("s_waitcnt vmcnt(0)" ::: "memory");
    __syncthreads();
    if (tid == 0) {
        unsigned* bar = b.bar;
        __builtin_amdgcn_s_waitcnt(0);
        unsigned nloc = b.st[0], nx = b.st[1];
        if (nloc == 0u) { xcd_barrier_complete(bar, b.x, nloc, nx); b.st[0] = nloc; b.st[1] = nx; }
        (void)__hip_atomic_fetch_add((GAS unsigned*)(ws + WS_CTL) + CW_FA, 1u, RLX_AGENT);
        const unsigned old = xb_add(&bar[XB_XSUB(b.x)], 1u);
        const unsigned gen = old / nloc;
        if (old + 1u == (gen + 1u) * nloc) {
            __builtin_amdgcn_fence(__ATOMIC_RELEASE, "agent");
            asm volatile("s_waitcnt vmcnt(0)" ::: "memory");
            const unsigned og = xb_add(&bar[XB_TOP], 1u);
            const unsigned tg = og / nx;
            if (og + 1u == (tg + 1u) * nx) xb_add(&bar[XB_TOPGEN], 1u);
            else XB_SPIN(xb_ld(&bar[XB_TOPGEN]) == tg, bar);
            __builtin_amdgcn_fence(__ATOMIC_ACQUIRE, "agent");
            xb_add(&bar[XB_XGEN(b.x)], 1u);
            asm volatile("s_waitcnt vmcnt(0)" ::: "memory");
            st[1] = 1;
        } else { st[1] = 0; st[2] = (int)gen; }
    }
    __syncthreads();
    if (st[1] == 0) {
        const int nb = (conv_count(fl) + NWAVES - 1) / NWAVES;
        bool dry = false; unsigned sp = 0u;
        for (;;) {
            if (tid == 0) {
                unsigned* bar = b.bar;
                int code = -1;
                const bool rel = xb_ld(&bar[XB_XGEN(b.x)]) != (unsigned)st[2] || ((++sp & 1023u) == 0u && xb_ld(&bar[XB_TMO]) != 0u);
                if (!rel && !dry) {
                    const unsigned G = gridDim.x, arr = __hip_atomic_load((GAS unsigned*)(ws + WS_CTL) + CW_FA, RLX_AGENT);
                    if (arr - (unsigned)nf * G < G - FILL_STOP) code = (int)__hip_atomic_fetch_add((GAS unsigned*)(ws + WS_CTL) + CW_FQ + 64 * fl, 1u, RLX_AGENT);
                }
                st[0] = code; st[1] = rel ? 1 : 0;
            }
            __syncthreads();
            const int code = __builtin_amdgcn_readfirstlane(st[0]); const int rel = __builtin_amdgcn_readfirstlane(st[1]);
            if (rel) break;
            if (code >= 0 && code < nb) conv_batch(args, ws, lds, fl, code, tid);
            else { if (code >= nb) dry = true; __builtin_amdgcn_s_sleep(2); }
            __syncthreads();
        }
        if (tid == 0) { __builtin_amdgcn_fence(__ATOMIC_ACQUIRE, "agent"); asm volatile("s_waitcnt vmcnt(0)" ::: "memory"); }
    }
    __syncthreads();
}

__device__ __forceinline__ void p0_prologue(Frame& F, const Args& args) {
    GAS unsigned char* ws = F.ws;
    if (F.bx == 0) { for (int e = F.tid; e < 64 * 16; e += NWAVES * 64) { const int pos = e >> 4, i = e & 15;
        const float inv = 1.0f / __builtin_powf(10000.0f, (float)(2 * i) / 32.0f); const float ang = (float)pos * inv;
        gf32* t = (gf32*)(ws + WS_ROPE) + 2 * e; t[0] = __builtin_cosf(ang); t[1] = __builtin_sinf(ang); } }
    {
        LAS float* S = (LAS float*)F.lds;
        cgf32* cin = GIN(1); cgf32* cctx = GIN(3); cgf32* w_ada = GIN(4); cgf32* b_ada = GIN(5); gf32* ada = (gf32*)(ws + WS_ADA);
        for (int cb = F.bx; cb < (DEPTH * NADA) / 256; cb += F.G) {
            __syncthreads();
            for (int k = F.tid; k < D; k += NWAVES * 64) {
                float v[17];
#pragma unroll
                for (int b = 0; b < 16; ++b) v[b] = cin[b * D + k];
                v[16] = cctx[k];
                __builtin_amdgcn_sched_barrier(0);
#pragma unroll
                for (int b = 0; b < 17; ++b) S[k * 17 + b] = v[b] / (1.0f + __expf(-v[b]));
            }
            __syncthreads();
            const int l = cb / (NADA / 256), cblk = cb % (NADA / 256), col = cblk * 256 + 4 * F.lane;
            cgf32* W = w_ada + (size_t)l * D * NADA + col;
            f32x4 acc[17];
#pragma unroll
            for (int b = 0; b < 17; ++b) acc[b] = (f32x4){0.f, 0.f, 0.f, 0.f};
            const int k0 = F.wave * 256;
            f32x4 w[8];
#pragma unroll
            for (int u = 0; u < 8; ++u) w[u] = __builtin_nontemporal_load((const GAS f32x4*)(W + (size_t)(k0 + u) * NADA));
            for (int kk = 0; kk < 256; kk += 8) {
                f32x4 wn[8]; const int kn = kk + 8 < 256 ? kk + 8 : kk;
#pragma unroll
                for (int u = 0; u < 8; ++u) wn[u] = __builtin_nontemporal_load((const GAS f32x4*)(W + (size_t)(k0 + kn + u) * NADA));
                __builtin_amdgcn_sched_barrier(0);
#pragma unroll
                for (int u = 0; u < 8; ++u) { const LAS float* sp = S + (k0 + kk + u) * 17;
#pragma unroll
                    for (int b = 0; b < 17; ++b) acc[b] += sp[b] * w[u]; }
                __builtin_amdgcn_sched_barrier(0);
#pragma unroll
                for (int u = 0; u < 8; ++u) w[u] = wn[u];
            }
            __syncthreads();
#pragma unroll
            for (int b = 0; b < 17; ++b) *(LAS f32x4*)(S + ((F.wave * 17 + b) * 256 + 4 * F.lane)) = acc[b];
            __syncthreads();
            for (int o = F.tid; o < 17 * 256; o += NWAVES * 64) { const int b = o >> 8, c = o & 255; float s = b_ada[l * NADA + cblk * 256 + c];
#pragma unroll
                for (int w = 0; w < 8; ++w) s += S[(w * 17 + b) * 256 + c];
                ada[(size_t)(l * 17 + b) * NADA + cblk * 256 + c] = s; }
        }
        asm volatile("s_waitcnt vmcnt(0)" ::: "memory");
        __syncthreads();
        if (F.tid == 0) { int nmine = 0; for (int cb = F.bx; cb < 2 * D / 256; cb += F.G) ++nmine;
            if (nmine) { __builtin_amdgcn_fence(__ATOMIC_RELEASE, "agent"); (void)__hip_atomic_fetch_add((GAS unsigned*)(ws + WS_CTL) + CW_ADA0, (unsigned)nmine, RLX_AGENT); } }
    }
    conv_drain(args, ws, F.lds, 0, F.tid);
}

struct ThinVec { cgf32* adaG; cgf32* wpost; cgf32* adaSc; cgf32* adaSh; cgf32* wpre; };
struct ThinIO { cgf32* xsL; cgf32* xsC; cgb16* xsB; gf32* xdL; gf32* xdC; gb16* xdB; cgb16* Y; cgb16* Y2; gb16* H; bool src_bf, dst_bf, write_h; };
__device__ __forceinline__ f32x4 bf4_to_f(const v2u v) { return (f32x4){__uint_as_float(v.x << 16), __uint_as_float(v.x & 0xffff0000u), __uint_as_float(v.y << 16), __uint_as_float(v.y & 0xffff0000u)}; }
template <bool HAS_Y>
__device__ __forceinline__ void thin_load_row(int r, const ThinIO& io, int lc, f32x4 (&x)[8], v2u (&xr)[8], v2u (&yr)[8], v2u (&y2r)[8]) {
    if (io.src_bf) {
#pragma unroll
        for (int j = 0; j < 8; ++j) xr[j] = __builtin_nontemporal_load((const GAS v2u*)(io.xsB + (size_t)r * D + 256 * j + lc));
    } else {
        cgf32* xs = r < ML ? io.xsL + (size_t)r * D : io.xsC + (size_t)(r - ML) * D;
#pragma unroll
        for (int j = 0; j < 8; ++j) x[j] = __builtin_nontemporal_load((const GAS f32x4*)(xs + 256 * j + lc));
    }
    if (HAS_Y) {
#pragma unroll
        for (int j = 0; j < 8; ++j) yr[j] = __builtin_nontemporal_load((const GAS v2u*)(io.Y + (size_t)r * D + 256 * j + lc));
        if (r >= ML) {
#pragma unroll
            for (int j = 0; j < 8; ++j) y2r[j] = __builtin_nontemporal_load((const GAS v2u*)(io.Y2 + (size_t)(r - ML) * D + 256 * j + lc)); }
    }
}
template <bool HAS_Y>
__device__ __forceinline__ void thin_proc_row(int r, const ThinIO& io, const LAS float* vec, int lc, f32x4 (&x)[8], const v2u (&xr)[8], const v2u (&yr)[8], const v2u (&y2r)[8]) {
    if (io.src_bf) {
#pragma unroll
        for (int j = 0; j < 8; ++j) x[j] = bf4_to_f(xr[j]);
    }
    if (HAS_Y) {
        f32x4 y[8]; float ss = 0.f;
#pragma unroll
        for (int j = 0; j < 8; ++j) { y[j] = bf4_to_f(yr[j]); if (r >= ML) y[j] += bf4_to_f(y2r[j]);
            ss += (y[j].x * y[j].x + y[j].y * y[j].y) + (y[j].z * y[j].z + y[j].w * y[j].w); }
        f32x4 gp[8];
#pragma unroll
        for (int j = 0; j < 8; ++j) gp[j] = *(const LAS f32x4*)(vec + 256 * j + lc);
        const float ry = 1.0f / sqrtf(wave_sum(ss) * (1.0f / D) + RMS_EPS);
#pragma unroll
        for (int j = 0; j < 8; ++j) x[j] += gp[j] * (y[j] * ry);
        if (io.dst_bf) {
#pragma unroll
            for (int j = 0; j < 8; ++j) { v2u o; o.x = cvtpk(x[j].x, x[j].y); o.y = cvtpk(x[j].z, x[j].w); __builtin_nontemporal_store(o, (GAS v2u*)(io.xdB + (size_t)r * D + 256 * j + lc)); x[j] = bf4_to_f(o); }
        } else {
            gf32* xd = r < ML ? io.xdL + (size_t)r * D : io.xdC + (size_t)(r - ML) * D;
#pragma unroll
            for (int j = 0; j < 8; ++j) __builtin_nontemporal_store(x[j], (GAS f32x4*)(xd + 256 * j + lc));
        }
    }
    if (io.write_h) {
        float ss = 0.f;
#pragma unroll
        for (int j = 0; j < 8; ++j) ss += (x[j].x * x[j].x + x[j].y * x[j].y) + (x[j].z * x[j].z + x[j].w * x[j].w);
        f32x4 wm[8];
#pragma unroll
        for (int j = 0; j < 8; ++j) wm[j] = *(const LAS f32x4*)(vec + D + 256 * j + lc);
        const float rx = 1.0f / sqrtf(wave_sum(ss) * (1.0f / D) + RMS_EPS);
        f32x4 sh[8];
#pragma unroll
        for (int j = 0; j < 8; ++j) sh[j] = *(const LAS f32x4*)(vec + 2 * D + 256 * j + lc);
#pragma unroll
        for (int j = 0; j < 8; ++j) { const f32x4 h = (x[j] * rx) * wm[j] + sh[j]; v2u o; o.x = cvtpk(h.x, h.y); o.y = cvtpk(h.z, h.w); *(GAS v2u*)(io.H + (size_t)r * D + 256 * j + lc) = o; }
    }
}
template <bool HAS_Y>
__device__ __forceinline__ void thin_phase(Frame& F, int M, const ThinIO io, const ThinVec tv) {
    const int NGW = F.G * NWAVES, gw = F.vcu * NWAVES + F.wave;
    const int rpl = (ML + NGW - 1) / NGW, l0 = gw * rpl < ML ? gw * rpl : ML, nl = (l0 + rpl < ML ? l0 + rpl : ML) - l0;
    const int Mc = M - ML, rpc = (Mc + NGW - 1) / NGW, c0r = gw * rpc < Mc ? gw * rpc : Mc, nc = (c0r + rpc < Mc ? c0r + rpc : Mc) - c0r, c0 = ML + c0r, nrow = nl + nc;
    const int wl0 = F.vcu * NWAVES * rpl < ML ? F.vcu * NWAVES * rpl : ML - 1, wl1 = (F.vcu * NWAVES + NWAVES) * rpl - 1 < ML ? (F.vcu * NWAVES + NWAVES) * rpl - 1 : ML - 1;
    const int bA = wl0 >> 11, bB = wl1 >> 11;
    LAS float* V = (LAS float*)F.lds;
    for (int e = F.tid; e < 3 * D; e += NWAVES * 64) { const int sl = e >> 11, c = e & (D - 1), b = sl == 0 ? bA : (sl == 1 ? bB : 16);
        if (HAS_Y) V[sl * 3 * D + c] = tv.adaG[(size_t)b * NADA + c] * tv.wpost[c];
        if (io.write_h) { V[sl * 3 * D + D + c] = tv.wpre[c] * (1.0f + tv.adaSc[(size_t)b * NADA + c]); V[sl * 3 * D + 2 * D + c] = tv.adaSh[(size_t)b * NADA + c]; } }
    __syncthreads();
    const int lc = 4 * F.lane;
    f32x4 xa[8], xb[8]; v2u xra[8], xrb[8], ya[8], yb[8], y2a[8], y2b[8];
#define THIN_ROW(i) ((i) < nl ? l0 + (i) : c0 + ((i) - nl))
#define THIN_VEC(r) (V + ((r) >= ML ? 6 * D : (((r) >> 11) != bA ? 3 * D : 0)))
    if (nrow > 0) thin_load_row<HAS_Y>(THIN_ROW(0), io, lc, xa, xra, ya, y2a);
    for (int i = 0; i < nrow; i += 2) {
        if (i + 1 < nrow) thin_load_row<HAS_Y>(THIN_ROW(i + 1), io, lc, xb, xrb, yb, y2b);
        { const int r = THIN_ROW(i); thin_proc_row<HAS_Y>(r, io, THIN_VEC(r), lc, xa, xra, ya, y2a); }
        if (i + 1 < nrow) {
            if (i + 2 < nrow) thin_load_row<HAS_Y>(THIN_ROW(i + 2), io, lc, xa, xra, ya, y2a);
            const int r = THIN_ROW(i + 1); thin_proc_row<HAS_Y>(r, io, THIN_VEC(r), lc, xb, xrb, yb, y2b);
        }
    }
#undef THIN_ROW
#undef THIN_VEC
    __syncthreads();
}

__device__ __forceinline__ void bf8_to_f(const v4u v, float (&f)[8]) {
    f[0] = __uint_as_float(v.x << 16); f[1] = __uint_as_float(v.x & 0xffff0000u); f[2] = __uint_as_float(v.y << 16); f[3] = __uint_as_float(v.y & 0xffff0000u);
    f[4] = __uint_as_float(v.z << 16); f[5] = __uint_as_float(v.z & 0xffff0000u); f[6] = __uint_as_float(v.w << 16); f[7] = __uint_as_float(v.w & 0xffff0000u);
}
__device__ __forceinline__ void pool_phase(Frame& F, int M, cgb16* H, gb16* P) {
    const int NGW = F.G * NWAVES, gw = F.vcu * NWAVES + F.wave, ntask = (M / 32) * 4;
    for (int task = gw; task < ntask; task += NGW) {
        const int g = task & 3, r0 = (task >> 2) * 32;
        const int s0 = r0 < ML ? (r0 & ~(SEQ - 1)) : ML + ((r0 - ML) & ~(CTXL - 1)), Ls = r0 < ML ? SEQ : CTXL, t0 = r0 - s0, half = 1 << g;
        cgb16* Hs = H + (size_t)s0 * D + g * 512 + 8 * F.lane; gb16* Ps = P + (size_t)s0 * D + g * 512 + 8 * F.lane;
        float S[8];
#pragma unroll
        for (int e = 0; e < 8; ++e) S[e] = 0.f;
        {
            v4u w[16];
#pragma unroll
            for (int i = 0; i < 16; ++i) { int tt = t0 - half + i; tt = tt < 0 ? 0 : (tt > Ls - 1 ? Ls - 1 : tt); w[i] = *(const GAS v4u*)(Hs + (size_t)tt * D); }
#pragma unroll
            for (int i = 0; i < 16; ++i) { const int tt = t0 - half + i; const float m = (i < 2 * half && tt >= 0 && tt < Ls) ? 1.f : 0.f; float f[8]; bf8_to_f(w[i], f);
#pragma unroll
                for (int e = 0; e < 8; ++e) S[e] += m * f[e]; }
        }
        for (int tb = t0; tb < t0 + 32; tb += 8) {
            v4u vc[8], va[8], vs[8];
#pragma unroll
            for (int i = 0; i < 8; ++i) { const int t = tb + i; const int ta = t + half > Ls - 1 ? Ls - 1 : t + half, ts = t - half < 0 ? 0 : t - half;
                vc[i] = *(const GAS v4u*)(Hs + (size_t)t * D); va[i] = *(const GAS v4u*)(Hs + (size_t)ta * D); vs[i] = *(const GAS v4u*)(Hs + (size_t)ts * D); }
#pragma unroll
            for (int i = 0; i < 8; ++i) { const int t = tb + i;
                const int lo = t - half > 0 ? t - half : 0, hi = t + half < Ls ? t + half : Ls; const float rc = 1.0f / (float)(hi - lo);
                float c[8]; bf8_to_f(vc[i], c);
                v4u o; o.x = cvtpk(S[0] * rc - c[0], S[1] * rc - c[1]); o.y = cvtpk(S[2] * rc - c[2], S[3] * rc - c[3]); o.z = cvtpk(S[4] * rc - c[4], S[5] * rc - c[5]); o.w = cvtpk(S[6] * rc - c[6], S[7] * rc - c[7]);
                *(GAS v4u*)(Ps + (size_t)t * D) = o;
                const float ma = (t + half < Ls) ? 1.f : 0.f, ms = (t - half >= 0) ? 1.f : 0.f; float fa[8], fs[8]; bf8_to_f(va[i], fa); bf8_to_f(vs[i], fs);
#pragma unroll
                for (int e = 0; e < 8; ++e) S[e] += ma * fa[e] - ms * fs[e]; }
        }
    }
}

namespace att {
constexpr int KPITCH = 144, KBUF = 64 * KPITCH, VPITCH = 144, VBUF = 64 * VPITCH, QPITCH = 144, QBUF = 64 * QPITCH;
constexpr int OFF_K = 0, OFF_V = 2 * KBUF, OFF_Q = 2 * KBUF + 2 * VBUF, ATT_LDS = OFF_Q + 8 * QBUF;
static_assert(ATT_LDS <= LDSCTL_OFF, "attention LDS");
__device__ __forceinline__ int crow(int i, int h) { return (i & 3) + 8 * (i >> 2) + 4 * h; }
#define ATT_BAR() asm volatile("s_waitcnt lgkmcnt(0)\n\ts_barrier" ::: "memory")
#define MFMA32(a, b, c) __builtin_amdgcn_mfma_f32_32x32x16_bf16((a), (b), (c), 0, 0, 0)
__device__ __forceinline__ void att_s(f32x16 (&s)[2][2], const LAS unsigned char* kb_, const LAS unsigned char* qs, int r, int h) {
#pragma unroll
    for (int ds = 0; ds < 4; ++ds) {
        bf16x8 kf[2], qf[2];
#pragma unroll
        for (int x = 0; x < 2; ++x) { kf[x] = *(const LAS bf16x8*)(kb_ + (32 * x + r) * KPITCH + 32 * ds + 16 * h); qf[x] = *(const LAS bf16x8*)(qs + (32 * x + r) * QPITCH + 32 * ds + 16 * h); }
#pragma unroll
        for (int kb = 0; kb < 2; ++kb)
#pragma unroll
            for (int qb = 0; qb < 2; ++qb) { if (ds == 0) { f32x16 z;
#pragma unroll
                    for (int i = 0; i < 16; ++i) z[i] = 0.f;
                    s[kb][qb] = MFMA32(kf[kb], qf[qb], z); } else s[kb][qb] = MFMA32(kf[kb], qf[qb], s[kb][qb]); }
    }
}
__device__ __forceinline__ void att_pv(f32x16 (&o)[2][2], const bf16x8 (&pf)[2][2][2], const LAS unsigned char* vb_, int r, int h) {
#pragma unroll
    for (int kb = 0; kb < 2; ++kb)
#pragma unroll
        for (int st = 0; st < 2; ++st)
#pragma unroll
            for (int db = 0; db < 2; ++db) { const LAS unsigned char* vp = vb_ + (32 * db + r) * VPITCH + (32 * kb + 16 * st + 4 * h) * 2; const s16x4 lo = *(const LAS s16x4*)vp, hi = *(const LAS s16x4*)(vp + 16);
                const bf16x8 vf = (bf16x8){lo[0], lo[1], lo[2], lo[3], hi[0], hi[1], hi[2], hi[3]};
#pragma unroll
                for (int qb = 0; qb < 2; ++qb) o[db][qb] = MFMA32(vf, pf[kb][st][qb], o[db][qb]); }
}
template <bool HAS_PV>
__device__ __forceinline__ void att_x(f32x16 (&o)[2][2], const bf16x8 (&pf)[2][2][2], f32x16 (&s)[2][2], const LAS unsigned char* vb_, const LAS unsigned char* kb_, const LAS unsigned char* qs, int r, int h) {
    s16x4 vlo[2][2][2], vhi[2][2][2];
    bf16x8 kf[4][2], qf[4][2];
#define ATT_LDV(kb) do { _Pragma("unroll") for (int st = 0; st < 2; ++st) _Pragma("unroll") for (int db = 0; db < 2; ++db) { const LAS unsigned char* vp = vb_ + (32 * db + r) * VPITCH + (32 * (kb) + 16 * st + 4 * h) * 2; \
        vlo[kb][st][db] = *(const LAS s16x4*)vp; vhi[kb][st][db] = *(const LAS s16x4*)(vp + 16); } } while (0)
#define ATT_LDKQ(ds) do { _Pragma("unroll") for (int x = 0; x < 2; ++x) { kf[ds][x] = *(const LAS bf16x8*)(kb_ + (32 * x + r) * KPITCH + 32 * (ds) + 16 * h); qf[ds][x] = *(const LAS bf16x8*)(qs + (32 * x + r) * QPITCH + 32 * (ds) + 16 * h); } } while (0)
#define ATT_PVMMA(kb) do { _Pragma("unroll") for (int st = 0; st < 2; ++st) _Pragma("unroll") for (int db = 0; db < 2; ++db) { \
        const bf16x8 vf = (bf16x8){vlo[kb][st][db][0], vlo[kb][st][db][1], vlo[kb][st][db][2], vlo[kb][st][db][3], vhi[kb][st][db][0], vhi[kb][st][db][1], vhi[kb][st][db][2], vhi[kb][st][db][3]}; \
        _Pragma("unroll") for (int qb = 0; qb < 2; ++qb) o[db][qb] = MFMA32(vf, pf[kb][st][qb], o[db][qb]); } } while (0)
#define ATT_SMMA(ds) do { _Pragma("unroll") for (int kb = 0; kb < 2; ++kb) _Pragma("unroll") for (int qb = 0; qb < 2; ++qb) { if ((ds) == 0) { f32x16 z; _Pragma("unroll") for (int i = 0; i < 16; ++i) z[i] = 0.f; \
        s[kb][qb] = MFMA32(kf[0][kb], qf[0][qb], z); } else s[kb][qb] = MFMA32(kf[ds][kb], qf[ds][qb], s[kb][qb]); } } while (0)
    if (HAS_PV) { ATT_LDV(0); ATT_LDV(1); __builtin_amdgcn_sched_barrier(0);
        ATT_PVMMA(0); ATT_LDKQ(0); ATT_LDKQ(1); __builtin_amdgcn_sched_barrier(0);
        ATT_PVMMA(1); ATT_LDKQ(2); ATT_LDKQ(3); __builtin_amdgcn_sched_barrier(0);
    } else { ATT_LDKQ(0); ATT_LDKQ(1); ATT_LDKQ(2); ATT_LDKQ(3); __builtin_amdgcn_sched_barrier(0); }
    ATT_SMMA(0); ATT_SMMA(1); ATT_SMMA(2); ATT_SMMA(3);
    __builtin_amdgcn_sched_barrier(0);
#undef ATT_LDV
#undef ATT_LDKQ
#undef ATT_PVMMA
#undef ATT_SMMA
}
__device__ __forceinline__ void att_softmax(f32x16 (&s)[2][2], f32x16 (&o)[2][2], bf16x8 (&pf)[2][2][2], float (&mx)[2], float (&l)[2], int j, int r, int h) {
    if (j == 0 || j == 4) {
        int rr = r, hh = h; asm volatile("" : "+v"(rr), "+v"(hh));
        const int dq = (j == 0) ? rr - 4 * hh : 4 * hh - rr;
#pragma unroll
        for (int kb = 0; kb < 2; ++kb)
#pragma unroll
            for (int qb = 0; qb < 2; ++qb)
#pragma unroll
                for (int i = 0; i < 16; ++i) { const int c = (32 * kb + (i & 3) + 8 * (i >> 2)) - 32 * qb; const bool bad = (j == 0) ? (dq > c) : (dq > -c); if (bad) s[kb][qb][i] = -1e30f; }
    }
    float mn[2]; bool grow = false;
#pragma unroll
    for (int qb = 0; qb < 2; ++qb) {
        float ra = fmaxf(fmaxf(s[0][qb][0], s[0][qb][1]), s[0][qb][2]), rb = fmaxf(fmaxf(s[1][qb][0], s[1][qb][1]), s[1][qb][2]);
#pragma unroll
        for (int i = 3; i < 15; i += 2) { ra = fmaxf(fmaxf(ra, s[0][qb][i]), s[0][qb][i + 1]); rb = fmaxf(fmaxf(rb, s[1][qb][i]), s[1][qb][i + 1]); }
        float rm = fmaxf(fmaxf(ra, rb), fmaxf(s[0][qb][15], s[1][qb][15]));
        rm = fmaxf(rm, __shfl_xor(rm, 32));
        mn[qb] = fmaxf(mx[qb], rm); grow = grow || (mn[qb] > mx[qb]);
    }
    if (__any(grow)) {
#pragma unroll
        for (int qb = 0; qb < 2; ++qb) { const float alpha = __builtin_amdgcn_exp2f(mx[qb] - mn[qb]); mx[qb] = mn[qb]; l[qb] *= alpha;
#pragma unroll
            for (int db = 0; db < 2; ++db)
#pragma unroll
                for (int i = 0; i < 16; ++i) o[db][qb][i] *= alpha; }
    }
#pragma unroll
    for (int qb = 0; qb < 2; ++qb) {
        float rs0 = 0.f, rs1 = 0.f;
#pragma unroll
        for (int i = 0; i < 16; ++i) { const float p0 = __builtin_amdgcn_exp2f(s[0][qb][i] - mx[qb]), p1 = __builtin_amdgcn_exp2f(s[1][qb][i] - mx[qb]); rs0 += p0; rs1 += p1; s[0][qb][i] = p0; s[1][qb][i] = p1; }
        l[qb] += rs0 + rs1;
    }
#pragma unroll
    for (int kb = 0; kb < 2; ++kb)
#pragma unroll
        for (int st = 0; st < 2; ++st)
#pragma unroll
            for (int qb = 0; qb < 2; ++qb) { v4u pw; pw.x = cvtpk(s[kb][qb][8 * st + 0], s[kb][qb][8 * st + 1]); pw.y = cvtpk(s[kb][qb][8 * st + 2], s[kb][qb][8 * st + 3]);
                pw.z = cvtpk(s[kb][qb][8 * st + 4], s[kb][qb][8 * st + 5]); pw.w = cvtpk(s[kb][qb][8 * st + 6], s[kb][qb][8 * st + 7]); pf[kb][st][qb] = __builtin_bit_cast(bf16x8, pw); }
}
__device__ __forceinline__ void attn_unit(LAS unsigned char* lds, cgb16* Q, cgb16* Kb, cgb16* Vt, gb16* O, cgf32* sinks, int qrow0, int kvh, int nloc, int jlo, int klocbase, int kctx0, const int tid) {
    const int lane = tid & 63, r = lane & 31, h = lane >> 5, wid = __builtin_amdgcn_readfirstlane(tid >> 6);
    const int head = kvh * 8 + wid, ntiles = nloc + 4; const bool trail = wid >= 4;
    LAS unsigned char* qs = lds + OFF_Q + wid * QBUF;
    const int skey = tid >> 3, sch = tid & 7;
#define ATT_TROW(i) ((i) < nloc ? klocbase + 64 * (jlo + (i)) : kctx0 + 64 * ((i) - nloc))
#define ATT_LOADK(i) (*(const GAS v4u*)(Kb + (size_t)(ATT_TROW(i) + skey) * KVD + kvh * HD + sch * 8))
#define ATT_LOADV(i) (*(const GAS v4u*)(Vt + ((size_t)(kvh * (MT / 64) + (ATT_TROW(i) >> 6)) * 64 + skey) * 64 + sch * 8))
#define ATT_WRK(slot, v) (*(LAS v4u*)(lds + OFF_K + (slot) * KBUF + skey * KPITCH + sch * 16) = (v))
#define ATT_WRV(slot, v) (*(LAS v4u*)(lds + OFF_V + (slot) * VBUF + skey * VPITCH + sch * 16) = (v))
    v4u kreg, vreg;
    {
        v4u qv[8];
#pragma unroll
        for (int it = 0; it < 8; ++it) qv[it] = __builtin_nontemporal_load((const GAS v4u*)(Q + (size_t)(qrow0 + (lane >> 3) + 8 * it) * D + head * HD + (lane & 7) * 8));
        kreg = ATT_LOADK(0);
#pragma unroll
        for (int it = 0; it < 8; ++it) *(LAS v4u*)(qs + ((lane >> 3) + 8 * it) * QPITCH + (lane & 7) * 16) = qv[it];
        ATT_WRK(0, kreg);
        kreg = ATT_LOADK(1); vreg = ATT_LOADV(0);
    }
    f32x16 o[2][2];
#pragma unroll
    for (int a = 0; a < 2; ++a)
#pragma unroll
        for (int b = 0; b < 2; ++b)
#pragma unroll
            for (int i = 0; i < 16; ++i) o[a][b][i] = 0.f;
    const float snk = sinks[head] * 1.4426950408889634f;
    float mx[2] = {snk, snk}, l[2] = {h == 0 ? 1.f : 0.f, h == 0 ? 1.f : 0.f};
    bf16x8 pf[2][2][2];
    f32x16 s[2][2];
    ATT_BAR();
    if (trail) ATT_BAR();
#define ATT_STAGE(t) do { if ((t) + 1 < ntiles) ATT_WRK(((t) + 1) & 1, kreg); ATT_WRV((t) & 1, vreg); if ((t) + 2 < ntiles) kreg = ATT_LOADK((t) + 2); if ((t) + 1 < ntiles) vreg = ATT_LOADV((t) + 1); } while (0)
    ATT_STAGE(0);
    att_x<false>(o, pf, s, lds + OFF_V, lds + OFF_K, qs, r, h);
    ATT_BAR();
    att_softmax(s, o, pf, mx, l, nloc > 0 ? jlo : -1, r, h);
    ATT_BAR();
    for (int t = 1; t < ntiles; ++t) {
        ATT_STAGE(t);
        att_x<true>(o, pf, s, lds + OFF_V + ((t - 1) & 1) * VBUF, lds + OFF_K + (t & 1) * KBUF, qs, r, h);
        ATT_BAR();
        att_softmax(s, o, pf, mx, l, t < nloc ? jlo + t : -1, r, h);
        ATT_BAR();
    }
    att_pv(o, pf, lds + OFF_V + ((ntiles - 1) & 1) * VBUF, r, h);
#undef ATT_STAGE
    if (!trail) ATT_BAR();
#pragma unroll
    for (int qb = 0; qb < 2; ++qb) {
        const float lt = l[qb] + __shfl_xor(l[qb], 32), inv = 1.0f / lt;
#pragma unroll
        for (int db = 0; db < 2; ++db)
#pragma unroll
            for (int g = 0; g < 4; ++g) { v2u w; w.x = cvtpk(o[db][qb][4 * g] * inv, o[db][qb][4 * g + 1] * inv); w.y = cvtpk(o[db][qb][4 * g + 2] * inv, o[db][qb][4 * g + 3] * inv);
                *(LAS v2u*)(qs + (32 * qb + r) * QPITCH + (32 * db + 8 * g + 4 * h) * 2) = w; }
    }
    asm volatile("s_waitcnt lgkmcnt(0)" ::: "memory");
#pragma unroll
    for (int it = 0; it < 8; ++it) { const int row = (lane >> 3) + 8 * it; const v4u v = *(const LAS v4u*)(qs + row * QPITCH + (lane & 7) * 16);
        *(GAS v4u*)(O + (size_t)(qrow0 + row) * D + head * HD + (lane & 7) * 8) = v; }
    asm volatile("s_waitcnt lgkmcnt(0)" ::: "memory");
#undef ATT_TROW
#undef ATT_LOADK
#undef ATT_LOADV
#undef ATT_WRK
#undef ATT_WRV
}
}

__device__ __forceinline__ void attn_phase(Frame& F, cgb16* Q, cgb16* Kb, cgb16* Vb, gb16* O, cgf32* sinks, bool with_ctx) {
    for (int u = F.vcu; u < NB * NKVH * (SEQ / 64); u += F.G) {
        const int qt = u & 31, kvh = (u >> 5) & 3, b = u >> 7, t0 = qt * 64;
        const int jlo = 2 - qt > 0 ? 2 - qt : 0, jhi = 33 - qt < 4 ? 33 - qt : 4;
        att::attn_unit(F.lds, Q, Kb, Vb, O, sinks, b * SEQ + t0, kvh, jhi - jlo + 1, jlo, b * SEQ + t0 - 128, ML + b * CTXL, F.tid);
    }
    if (with_ctx) for (int u = F.vcu; u < NB * NKVH * (CTXL / 64); u += F.G) {
        const int qt = u & 3, kvh = (u >> 2) & 3, b = u >> 4;
        att::attn_unit(F.lds, Q, Kb, Vb, O, sinks, ML + b * CTXL + qt * 64, kvh, 0, 0, 0, ML + b * CTXL, F.tid);
    }
}

#define WSP(T, off) ((T)(F.ws + (off)))
#define FRAME_INIT(F) do { F.lds = (LAS unsigned char*)lds; F.MISC = (volatile LAS unsigned*)(F.lds + MISC_OFF); F.tid = threadIdx.x; asm volatile("" : "+v"(F.tid)); F.lane = F.tid & 63; F.wave = __builtin_amdgcn_readfirstlane(F.tid >> 6); \
    F.G = gridDim.x; F.bx = blockIdx.x; asm volatile("" : "+s"(F.bx)); F.vcu = (F.G % 8 == 0) ? (F.bx % 8) * (F.G / 8) + F.bx / 8 : F.bx; { unsigned char* w_ = args.ws; asm volatile("" : "+s"(w_)); F.ws = (GAS unsigned char*)w_; } F.ctl = (gu32*)(F.ws + WS_CTL); } while (0)
__global__ void __launch_bounds__(NWAVES * 64, 2) trunk_fwd(Args args) {
    extern __shared__ __attribute__((aligned(16))) unsigned char lds[];
    for (int u = threadIdx.x; u < (LDS_BYTES - LDSCTL_OFF) / 4; u += NWAVES * 64) ((LAS unsigned*)((LAS unsigned char*)lds + LDSCTL_OFF))[u] = 0u;
    __syncthreads();
    (void)xcd_barrier_post((unsigned*)(args.ws + WS_CTL) + CW_BAR, (volatile LAS unsigned*)((LAS unsigned char*)lds + MISC_OFF) + 8);

#define SEAM_(fillok) do { XcdBarrier bar_; unsigned char* w_ = args.ws; asm volatile("" : "+s"(w_)); bar_.bar = (unsigned*)((GAS unsigned*)(w_ + WS_CTL) + CW_BAR); bar_.x = xb_xcc_id(); bar_.st = (volatile LAS unsigned*)((LAS unsigned char*)lds + MISC_OFF) + 8; \
    if ((fillok) && fill_l >= 1 && fill_l < DEPTH) { int t_ = threadIdx.x; asm volatile("" : "+v"(t_)); xcd_barrier_fill(bar_, args, (GAS unsigned char*)w_, (LAS unsigned char*)lds, fill_l, nfill, t_); ++nfill; } else xcd_barrier(bar_); } while (0)
#define SEAM() SEAM_(false)
#define SEAM_F() SEAM_(true)

    int nfill = 0;
    int fill_l = 1;
    { Frame F; FRAME_INIT(F); p0_prologue(F, args); }
    { Frame F; FRAME_INIT(F); cgf32* ada = WSP(cgf32*, WS_ADA);
        if (F.tid == 0) { unsigned* bar_ = (unsigned*)((GAS unsigned*)(F.ws + WS_CTL) + CW_BAR); unsigned* f_ = (unsigned*)((GAS unsigned*)(F.ws + WS_CTL) + CW_ADA0);
            XB_SPIN(xb_ld(f_) < (unsigned)(2 * D / 256), bar_); __builtin_amdgcn_fence(__ATOMIC_ACQUIRE, "agent"); }
        __syncthreads();
        thin_phase<false>(F, MT, ThinIO{GIN(0), GIN(2), nullptr, nullptr, nullptr, nullptr, nullptr, nullptr, WSP(gb16*, WS_H), false, false, true}, ThinVec{nullptr, nullptr, ada + 1 * D, ada + 0 * D, GIN(6)}); }
    SEAM();

    for (int s = 0; s < 2 * DEPTH; ++s) {
        fill_l = (s >> 1) + 1;
        if (!(s & 1)) {
            if (!(s & 2)) {
                { Frame F; FRAME_INIT(F); pool_phase(F, MT, WSP(cgb16*, WS_H), WSP(gb16*, WS_P)); }
                SEAM();
            } else {
                { Frame F; FRAME_INIT(F); const int l = s >> 1;
                    pg8::Gemm g{WSP(cgb16*, WS_H), WSP(cgb16*, WS_WQKV) + (size_t)(l >> 1) * NQKV * D, MT, NQKV, D, D, D, 0, 0}; pg8::StaticOrder S; S.init(MT, NQKV, F.G, F.bx, WGM_QKV);
                    pg8::EpiQKV E{WSP(gb16*, WS_Q), WSP(gb16*, WS_K), WSP(gb16*, WS_V), WSP(cgf32*, WS_ROPE), ML, MT / 64};
                    pg8::gemm_phase<pg8::EpiQKV, pg8::StaticOrder>(F.lds, F.tid, g, S, E); }
                SEAM_F();
                { Frame F; FRAME_INIT(F); const int l = s >> 1;
                    attn_phase(F, WSP(cgb16*, WS_Q), WSP(cgb16*, WS_K), WSP(cgb16*, WS_V), WSP(gb16*, WS_O), GIN(14) + (l >> 1) * NHEAD, l != DEPTH - 1); }
                SEAM_F();
            }
        } else {
            { Frame F; FRAME_INIT(F); const int l = s >> 1; const int Mx = (l == DEPTH - 1) ? ML : MT;
                pg8::Gemm g{WSP(cgb16*, WS_H), WSP(cgb16*, WS_WGU) + (size_t)l * NGU * D, Mx, NGU, D, D, D, 0, 0}; pg8::DynOrder S; S.init(Mx, NGU, F.G, F.bx, WGM_GU, WSP(GAS unsigned*, WS_CTL) + CW_DQ + l * 512, (volatile LAS int*)(F.lds + MISC_OFF) + 32);
                pg8::EpiSwiGLU E{WSP(gb16*, WS_ACT), DFF};
                pg8::gemm_phase<pg8::EpiSwiGLU, pg8::DynOrder, SWI_ALIGN, SWI_SP2>(F.lds, F.tid, g, S, E); }
            SEAM_F();
        }
        { Frame F; FRAME_INIT(F); const int l = s >> 1; const int Mx = (l == DEPTH - 1) ? ML : MT;
            pg8::Gemm gp; cgf32* cscale = nullptr;
            if (s & 1) gp = pg8::Gemm{WSP(cgb16*, WS_ACT), WSP(cgb16*, WS_WD) + (size_t)l * D * DFF, Mx, D, DFF, DFF, DFF, 0, 0};
            else if (s & 2) gp = pg8::Gemm{WSP(cgb16*, WS_O), WSP(cgb16*, WS_WO) + (size_t)(l >> 1) * D * D, Mx, D, D, D, D, 0, 0};
            else { gp = pg8::Gemm{WSP(cgb16*, WS_P), WSP(cgb16*, WS_WP) + (size_t)(l >> 1) * D * 512, MT, D, 512, D, 512, 2, 512}; cscale = GIN(11) + (l >> 1) * D; }
            const int nparts = (gp.M > ML) ? 3 : 1, Gh = (F.G & 1) ? F.G : F.G / 2;
            for (int part = 0; part < nparts; ++part) {
                pg8::Gemm gq = gp; pg8::StaticOrder S; gb16* Op = WSP(gb16*, WS_Y);
                if (part == 0) { gq.M = ML; S.init(ML, gp.N, F.G, F.bx, WGM_PL); }
                else { const int hf = part - 1, Kh = gp.K / 2; gq.A = gp.A + (size_t)ML * gp.lda + hf * Kh; gq.Bt = gp.Bt + hf * Kh; gq.K = Kh; gq.M = MC;
                    S.init(MC, gp.N, Gh, F.bx % Gh); if (!(F.G & 1) && F.bx / Gh != hf) S.nwg = 0;
                    Op = hf ? WSP(gb16*, WS_Y2) : WSP(gb16*, WS_Y) + (size_t)ML * D; }
                pg8::EpiPlain E{Op, D, cscale};
                pg8::gemm_phase<pg8::EpiPlain, pg8::StaticOrder>(F.lds, F.tid, gq, S, E);
            } }
        SEAM_F();
        { Frame F; FRAME_INIT(F); const int l = s >> 1; if ((s & 1) && l + 1 < DEPTH) conv_drain(args, F.ws, F.lds, l + 1, F.tid); const bool lastl = (l == DEPTH - 1); const int Mx = lastl ? ML : MT;
            cgf32* adal = WSP(cgf32*, WS_ADA) + (size_t)l * 17 * NADA; const int ln = lastl ? l : l + 1; cgf32* adan = WSP(cgf32*, WS_ADA) + (size_t)ln * 17 * NADA;
            const bool odd = s & 1;
            const bool fin = (s == 2 * DEPTH - 1);
            thin_phase<true>(F, Mx, ThinIO{GIN(0), GIN(2), WSP(cgb16*, WS_XB), (gf32*)args.out, nullptr, WSP(gb16*, WS_XB), WSP(cgb16*, WS_Y), WSP(cgb16*, WS_Y2), WSP(gb16*, WS_H), s != 0, !fin, !fin},
                             ThinVec{adal + (odd ? 5 : 2) * D, (odd ? GIN(9) : GIN(7)) + l * D, odd ? adan + 1 * D : adal + 4 * D, odd ? adan + 0 * D : adal + 3 * D, odd ? GIN(6) + ln * D : GIN(8) + l * D}); }
        if (s < 2 * DEPTH - 1) SEAM();
    }
#undef IN
#undef SEAM
#undef SEAM_F
#undef SEAM_
}

constexpr int N_PHASES = 2 + 2 * (3 + 3) + 2 * (4 + 3);

extern "C" void kernel_launch(void* const* d_in, const int* in_sizes, int n_in, void* d_out, int out_size, void* d_ws, size_t ws_size, hipStream_t stream) {
    static int grid = 0;
    if (grid == 0) {
        if (n_in != 17 || in_sizes[0] != ML * D || out_size != ML * D || ws_size < WS_END) { fprintf(stderr, "kernel_launch: unexpected shapes (n_in %d, in0 %d, out %d, ws %zu); nothing launched\n", n_in, n_in > 0 ? in_sizes[0] : -1, out_size, ws_size); grid = -1; return; }
        int dev = 0, cus = 0, per_cu = 0;
        if (hipGetDevice(&dev) != hipSuccess || hipDeviceGetAttribute(&cus, hipDeviceAttributeMultiprocessorCount, dev) != hipSuccess) { fprintf(stderr, "kernel_launch: device query failed\n"); grid = -1; return; }
        if (hipFuncSetAttribute((const void*)trunk_fwd, hipFuncAttributeMaxDynamicSharedMemorySize, LDS_BYTES) != hipSuccess) { fprintf(stderr, "kernel_launch: hipFuncSetAttribute failed\n"); grid = -1; return; }
        if (hipOccupancyMaxActiveBlocksPerMultiprocessor(&per_cu, (const void*)trunk_fwd, NWAVES * 64, LDS_BYTES) != hipSuccess || per_cu < 1)
            fprintf(stderr, "kernel_launch: note: occupancy query reports %d workgroups per CU\n", per_cu);
        (void)hipGetLastError();
        grid = cus;
    }
    if (grid < 0) return;
    if (hipMemsetAsync((char*)d_ws + WS_CTL, 0, CTL_ZERO_BYTES, stream) != hipSuccess) { fprintf(stderr, "kernel_launch: memset failed\n"); return; }
    Args a{};
    for (int i = 0; i < 17; ++i) a.in[i] = (const float*)d_in[i];
    a.out = (float*)d_out; a.ws = (unsigned char*)d_ws;
    a.ph_lo = 0; a.ph_hi = N_PHASES;
    hipLaunchKernelGGL(trunk_fwd, dim3(grid), dim3(NWAVES * 64), LDS_BYTES, stream, a);
    const hipError_t le = hipPeekAtLastError();
    if (le != hipSuccess) fprintf(stderr, "kernel_launch: launch failed: %s\n", hipGetErrorName(le));
}
```

```cpp
#include <hip/hip_runtime.h>
#include <cstdio>
#include <cstdint>

#ifndef WGM_GU
#define WGM_GU 8
#endif
#ifndef WGM_PL
#define WGM_PL 2
#endif
#ifndef WGM_QKV
#define WGM_QKV 8
#endif
#ifndef FILL_STOP
#define FILL_STOP 16u
#endif
#ifndef SWI_SP2
#define SWI_SP2 true
#endif
#ifndef SWI_ALIGN
#define SWI_ALIGN true
#endif

#define GAS __attribute__((address_space(1)))
#define LAS __attribute__((address_space(3)))
namespace pg8 {
#define PG8_LAS __attribute__((address_space(3)))
typedef unsigned short bf16_t;
typedef short bf16x8 __attribute__((ext_vector_type(8)));
typedef float f32x4 __attribute__((ext_vector_type(4)));
typedef float f32x2 __attribute__((ext_vector_type(2)));
typedef unsigned u32x4 __attribute__((ext_vector_type(4)));
typedef unsigned u32x2 __attribute__((ext_vector_type(2)));
typedef __bf16 bf16x2_t __attribute__((ext_vector_type(2)));
constexpr int BM = 256, BK = 64, HALF = 128, HTB = HALF * BK * 2  , STAGE_BYTES = 8 * HTB, NXCD = 8;

__host__ __device__ __forceinline__ int lds_byte(int r, int c) { const int st = (r >> 4) * 2 + (c >> 5), rr = r & 15, cc = c & 31, ob = rr * 64 + cc * 2; return st * 1024 + (ob ^ (((ob >> 9) & 1) << 5)); }
__host__ __device__ __forceinline__ void stage_rc(int b, int& R, int& C) { const int st = b / 1024, sb = b % 1024, swz = sb ^ (((sb >> 9) & 1) << 5); R = (st >> 1) * 16 + swz / 64; C = (st & 1) * 32 + (swz % 64) / 2; }
__host__ __device__ __forceinline__ int perm32(int rho) { const int n = rho >> 4, i = rho & 15; return 8 * (i >> 2) + 4 * n + (i & 3); }

struct Unit { int pm, pn; };
struct Gemm { const GAS bf16_t* A; const GAS bf16_t* Bt; int M, N, K, lda, ldb, agrp, agst; };

struct StaticOrder {
    static constexpr bool DYN = false;
    int nM, nN, nwg, G, c, WGM, rev;
    __host__ __device__ void init(int M, int N, int G_, int c_, int wgm = 4) { nM = M / BM; nN = N / BM; nwg = nM * nN; G = G_; c = c_; WGM = wgm; rev = 0; }
    __host__ __device__ bool next(int i, Unit& u) const {
        const long L = (long)i * G + c; if (L >= nwg) return false;
        int wgid = (int)L; { const int q = nwg / NXCD, r = nwg % NXCD, xcd = wgid % NXCD, cnt = xcd < r ? q + 1 : q; int off = wgid / NXCD; if (rev) off = cnt - 1 - off;
            wgid = (xcd < r ? xcd * (q + 1) : r * (q + 1) + (xcd - r) * q) + off; }
        const int nig = WGM * nN, gid = wgid / nig, fm = gid * WGM, gsz = (nM - fm) < WGM ? (nM - fm) : WGM;
        u.pm = fm + ((wgid % nig) % gsz); u.pn = (wgid % nig) / gsz; return true;
    }
};

struct DynOrder {
    static constexpr bool DYN = true;
    int nM, nN, nwg, G, c, WGM; GAS unsigned* heads; PG8_LAS volatile int* slot;
    __device__ void init(int M, int N, int G_, int c_, int wgm, GAS unsigned* h, PG8_LAS volatile int* sl) { nM = M / BM; nN = N / BM; nwg = nM * nN; G = G_; c = c_; WGM = wgm; heads = h; slot = sl; }
    __device__ void chunk(int x, int& base, int& cnt) const { const int q = nwg / NXCD, r = nwg % NXCD; cnt = x < r ? q + 1 : q; base = x < r ? x * (q + 1) : r * (q + 1) + (x - r) * q; }
    __device__ int dealt(int x) const { return (2 * G - x + NXCD - 1) / NXCD; }
    __device__ void map(int wgid, Unit& u) const {
        const int nig = WGM * nN, gid = wgid / nig, fm = gid * WGM, gsz = (nM - fm) < WGM ? (nM - fm) : WGM;
        u.pm = fm + ((wgid % nig) % gsz); u.pn = (wgid % nig) / gsz; }
    __device__ bool next(int i, Unit& u) const {
        const long L = (long)i * G + c; if (L >= nwg) return false;
        int base, cnt; chunk((int)(L % NXCD), base, cnt); map(base + (int)(L / NXCD), u); return true; }
    __device__ unsigned issue(int tid, int hq) const {
        unsigned v = 0u;
        if (tid < NXCD) v = __hip_atomic_fetch_add(heads + ((hq + tid) & (NXCD - 1)) * 64, tid == 0 ? 1u : 0u, __ATOMIC_RELAXED, __HIP_MEMORY_SCOPE_AGENT);
        return v; }
    __device__ bool resolve(int tid, unsigned pend, int& hq, Unit& u) const {
        if (tid < 64) {
            int w = -1, qs = hq;
#pragma unroll 1
            for (int k = 0; k < NXCD; ++k) {
                const int q = (hq + k) & (NXCD - 1); int base, cnt; chunk(q, base, cnt);
                unsigned t = (unsigned)__builtin_amdgcn_readlane((int)pend, k);
                int off = dealt(q) + (int)t;
                if (off >= cnt) continue;
                if (k > 0) { unsigned tt = 0u; if (tid == 0) tt = __hip_atomic_fetch_add(heads + q * 64, 1u, __ATOMIC_RELAXED, __HIP_MEMORY_SCOPE_AGENT);
                    t = (unsigned)__builtin_amdgcn_readfirstlane((int)tt); off = dealt(q) + (int)t; if (off >= cnt) continue; }
                w = base + off; qs = q; break;
            }
            if (tid == 0) { slot[0] = w; slot[1] = qs; }
        }
        asm volatile("s_waitcnt lgkmcnt(0)" ::: "memory"); __builtin_amdgcn_s_barrier();
        const int w = __builtin_amdgcn_readfirstlane(slot[0]); hq = __builtin_amdgcn_readfirstlane(slot[1]);
        if (w < 0) return false;
        map(w, u); return true; }
};

__device__ __forceinline__ unsigned cvtpk(float lo, float hi) { f32x2 v = {lo, hi}; bf16x2_t b = __builtin_convertvector(v, bf16x2_t); return __builtin_bit_cast(unsigned, b); }


struct EpiPlain {
    static constexpr bool PERM = true;
    GAS bf16_t* O; int ldc; const GAS float* cscale;
    __device__ __forceinline__ void operator()(const f32x4 (&acc)[2][2][4][2], const Unit& u, int wr, int wc, int fr, int fq) const {
        const int row0 = u.pm * BM + wr * 64 + fr, col0 = u.pn * BM + wc * 32 + 8 * fq;
        f32x4 sv[2][2];
#pragma unroll
        for (int bj = 0; bj < 2; ++bj)
#pragma unroll
            for (int n = 0; n < 2; ++n) sv[bj][n] = cscale ? *(const GAS f32x4*)(cscale + col0 + bj * HALF + 4 * n) : (f32x4){1.f, 1.f, 1.f, 1.f};
#pragma unroll
        for (int ai = 0; ai < 2; ++ai)
#pragma unroll
            for (int m = 0; m < 4; ++m) { GAS bf16_t* rowp = O + (size_t)(row0 + ai * HALF + m * 16) * ldc + col0;
#pragma unroll
                for (int bj = 0; bj < 2; ++bj) { const f32x4 v0 = acc[ai][bj][m][0] * sv[bj][0], v1 = acc[ai][bj][m][1] * sv[bj][1];
                    u32x4 w; w.x = cvtpk(v0[0], v0[1]); w.y = cvtpk(v0[2], v0[3]); w.z = cvtpk(v1[0], v1[1]); w.w = cvtpk(v1[2], v1[3]);
                    *(GAS u32x4*)(rowp + bj * HALF) = w; } }
    }
};
__device__ __forceinline__ float silu_mul(float g, float u) { return g * u * __builtin_amdgcn_rcpf(1.0f + __builtin_amdgcn_exp2f(-1.4426950408889634f * g)); }
struct EpiSwiGLU {
    static constexpr bool PERM = true;
    GAS bf16_t* O; int ldc;
    __device__ __forceinline__ void operator()(const f32x4 (&acc)[2][2][4][2], const Unit& u, int wr, int wc, int fr, int fq) const {
        const int row0 = u.pm * BM + wr * 64 + fr, col0 = u.pn * HALF + wc * 32 + 8 * fq;
#pragma unroll
        for (int ai = 0; ai < 2; ++ai)
#pragma unroll
            for (int m = 0; m < 4; ++m) { GAS bf16_t* rowp = O + (size_t)(row0 + ai * HALF + m * 16) * ldc + col0;
                const f32x4 g0 = acc[ai][0][m][0], g1 = acc[ai][0][m][1], u0 = acc[ai][1][m][0], u1 = acc[ai][1][m][1];
                u32x4 w; w.x = cvtpk(silu_mul(g0[0], u0[0]), silu_mul(g0[1], u0[1])); w.y = cvtpk(silu_mul(g0[2], u0[2]), silu_mul(g0[3], u0[3]));
                w.z = cvtpk(silu_mul(g1[0], u1[0]), silu_mul(g1[1], u1[1])); w.w = cvtpk(silu_mul(g1[2], u1[2]), silu_mul(g1[3], u1[3]));
                __builtin_nontemporal_store(w, (GAS u32x4*)rowp); }
    }
};
struct EpiQKV {
    static constexpr bool PERM = false;
    GAS bf16_t* Q; GAS bf16_t* Kb; GAS bf16_t* Vb; const GAS float* tab; int nlat, vld;
    PG8_LAS unsigned char* scr;
    __device__ __forceinline__ void operator()(const f32x4 (&acc)[2][2][4][2], const Unit& u, int wr, int wc, int fr, int fq) const {
        const int row0 = u.pm * BM + wr * 64 + fr;
        if (u.pn == 9) {
            const int lane = fr + 16 * fq; PG8_LAS unsigned char* sb = scr + (wr * 4 + wc) * 1984;
#pragma unroll
            for (int ai = 0; ai < 2; ++ai) { const int tile = u.pm * (BM / 64) + wr + 2 * ai;
#pragma unroll
                for (int bj = 0; bj < 2; ++bj)
#pragma unroll
                    for (int n = 0; n < 2; ++n)
#pragma unroll
                        for (int mh = 0; mh < 2; ++mh) {
#pragma unroll
                            for (int mm = 0; mm < 2; ++mm) { const f32x4 v = acc[ai][bj][2 * mh + mm][n]; const unsigned w0 = cvtpk(v[0], v[1]), w1 = cvtpk(v[2], v[3]);
                                PG8_LAS bf16_t* q = (PG8_LAS bf16_t*)(sb + (4 * fq) * 80 + (16 * mm + fr) * 2);
                                q[0] = (bf16_t)(w0 & 0xffffu); q[40] = (bf16_t)(w0 >> 16); q[80] = (bf16_t)(w1 & 0xffffu); q[120] = (bf16_t)(w1 >> 16); }
                            asm volatile("" ::: "memory");
                            const u32x4 o = *(const PG8_LAS u32x4*)(sb + (lane >> 2) * 80 + (lane & 3) * 16);
                            *(GAS u32x4*)(Vb + ((size_t)((2 * bj + (wc >> 1)) * vld + tile) * 64 + (32 * (wc & 1) + 16 * n + (lane >> 2))) * 64 + 32 * mh + 8 * (lane & 3)) = o;
                            asm volatile("" ::: "memory");
                        } }
            return;
        }
        const bool isq = u.pn < 8; const float sc = isq ? 0.125f * 1.4426950408889634f : 1.0f;   const bool lat = u.pm * BM < nlat;
        GAS bf16_t* base = isq ? Q + (size_t)u.pn * BM : Kb; const int ldc = isq ? 2048 : 256; const int col0 = wc * 32 + 8 * fq;
#pragma unroll
        for (int ai = 0; ai < 2; ++ai)
#pragma unroll
            for (int m = 0; m < 4; ++m) { const int row = row0 + ai * HALF + m * 16; GAS bf16_t* rowp = base + (size_t)row * ldc + col0;
                f32x4 cs0 = {1.f, 0.f, 1.f, 0.f}, cs1 = {1.f, 0.f, 1.f, 0.f};
                if (lat) { const int t = row & 2047, pos = (wc & 1) ? (t & 63) : (t >> 6); const GAS f32x4* tp = (const GAS f32x4*)(tab + (size_t)(pos * 16 + 4 * fq) * 2); cs0 = tp[0]; cs1 = tp[1]; }
#pragma unroll
                for (int bj = 0; bj < 2; ++bj) { const f32x4 x1 = acc[ai][bj][m][0] * sc, x2 = acc[ai][bj][m][1] * sc;
                    const float a0 = x1[0] * cs0[0] - x2[0] * cs0[1], a1 = x1[1] * cs0[2] - x2[1] * cs0[3], a2 = x1[2] * cs1[0] - x2[2] * cs1[1], a3 = x1[3] * cs1[2] - x2[3] * cs1[3];
                    const float b0 = x2[0] * cs0[0] + x1[0] * cs0[1], b1 = x2[1] * cs0[2] + x1[1] * cs0[3], b2 = x2[2] * cs1[0] + x1[2] * cs1[1], b3 = x2[3] * cs1[2] + x1[3] * cs1[3];
                    u32x4 w; w.x = cvtpk(a0, a1); w.y = cvtpk(a2, a3); w.z = cvtpk(b0, b1); w.w = cvtpk(b2, b3);
                    *(GAS u32x4*)(rowp + bj * HALF) = w; } }
    }
};

template <class Epi, class Sched, bool ALIGN_EPI = true, bool SP2 = true>
__device__ __forceinline__ void gemm_phase(PG8_LAS unsigned char* lds, const int tid, const Gemm g, const Sched& S, const Epi& E) {
    const int wid = __builtin_amdgcn_readfirstlane(tid >> 6), lane = tid & 63, wr = wid >> 2, wc = wid & 3, fr = lane & 15, fq = lane >> 4;
    const int K = g.K, nt = K / BK;
    unsigned voffA[2], voffB[2];
#pragma unroll
    for (int i = 0; i < 2; ++i) { int R, C; stage_rc(tid * 16 + i * 8192, R, C); const int Rb = Epi::PERM ? ((R & ~31) + perm32(R & 31)) : R;
        voffA[i] = (unsigned)(R * g.lda + C) * 2u; voffB[i] = (unsigned)(Rb * g.ldb + C) * 2u; }
    const size_t kstep = (size_t)(BK * 2);
    const size_t hstepA = (size_t)HALF * g.lda * 2, hstepB = (size_t)HALF * g.ldb * 2;
    const size_t tstepA = 2 * hstepA, tstepB = 2 * hstepB;
    const unsigned ldsw = (unsigned)wid * 1024u;
    const int aoff = lds_byte(wr * 64 + fr, fq * 8), boff = lds_byte(wc * 32 + fr, fq * 8);
#define PG8_SA(b, h) (((b) * 2 + (h)) * HTB)
#define PG8_SB(b, h) ((4 + (b) * 2 + (h)) * HTB)
#define PG8_STAGE(bufoff, gbase, voff) do { _Pragma("unroll") for (int _i = 0; _i < 2; ++_i) \
        __builtin_amdgcn_global_load_lds((const GAS unsigned*)((const GAS char*)(gbase) + (voff)[_i]), (PG8_LAS unsigned*)(lds + (bufoff) + ldsw + _i * 8192), 16, 0, 0); } while (0)
#define PG8_LDA(dst, b, h) do { _Pragma("unroll") for (int m = 0; m < 4; ++m) _Pragma("unroll") for (int k = 0; k < 2; ++k) dst[m][k] = *(const PG8_LAS bf16x8*)(lds + PG8_SA(b, h) + aoff + m * 2048 + k * 1024); } while (0)
#define PG8_LDB(dst, b, h) do { _Pragma("unroll") for (int n = 0; n < 2; ++n) _Pragma("unroll") for (int k = 0; k < 2; ++k) dst[n][k] = *(const PG8_LAS bf16x8*)(lds + PG8_SB(b, h) + boff + n * 2048 + k * 1024); } while (0)
#define PG8_MMA(ai, bj, At, Bt) do { __builtin_amdgcn_s_setprio(1); _Pragma("unroll") for (int m = 0; m < 4; ++m) _Pragma("unroll") for (int n = 0; n < 2; ++n) _Pragma("unroll") for (int k = 0; k < 2; ++k) \
        acc[ai][bj][m][n] = __builtin_amdgcn_mfma_f32_16x16x32_bf16(Bt[n][k], At[m][k], acc[ai][bj][m][n], 0, 0, 0); __builtin_amdgcn_s_setprio(0); } while (0)
#define PG8_WAIT_V(n) asm volatile("s_waitcnt vmcnt(" #n ")" ::: "memory")
#define PG8_WAIT_L(n) asm volatile("s_waitcnt lgkmcnt(" #n ")" ::: "memory")
#define PG8_BAR __builtin_amdgcn_s_barrier()
#define PG8_SCHED __builtin_amdgcn_sched_barrier(0)
#define PG8_ABASE(u) ((const GAS char*)g.A + (size_t)(u).pm * tstepA + (g.agrp ? (size_t)((u).pn / g.agrp) * (size_t)g.agst * 2 : (size_t)0))
    Unit cur, nxt; int ui = 0;
    if (!S.next(0, cur)) return;
    __builtin_amdgcn_s_waitcnt(0);
    f32x4 acc[2][2][4][2];
#pragma unroll
    for (int a = 0; a < 2; ++a)
#pragma unroll
        for (int b = 0; b < 2; ++b)
#pragma unroll
            for (int m = 0; m < 4; ++m)
#pragma unroll
                for (int n = 0; n < 2; ++n) acc[a][b][m][n] = (f32x4){0.f, 0.f, 0.f, 0.f};
    bf16x8 At[4][2], B0[2][2], B1[2][2];
    const GAS char* cA = PG8_ABASE(cur); const GAS char* cB = (const GAS char*)g.Bt + (size_t)cur.pn * tstepB;
    if constexpr (SP2) {
        PG8_STAGE(PG8_SB(0, 0), cB, voffB); PG8_STAGE(PG8_SB(0, 1), cB + hstepB, voffB); PG8_STAGE(PG8_SA(0, 0), cA, voffA); PG8_STAGE(PG8_SA(0, 1), cA + hstepA, voffA);
        if (wr == 1) PG8_BAR;
        PG8_WAIT_V(2); PG8_BAR;
        PG8_STAGE(PG8_SB(1, 0), cB + kstep, voffB); PG8_STAGE(PG8_SA(1, 0), cA + kstep, voffA); PG8_STAGE(PG8_SB(1, 1), cB + hstepB + kstep, voffB);
        PG8_WAIT_V(6); PG8_BAR;
    } else {
        PG8_STAGE(PG8_SB(0, 0), cB, voffB); PG8_STAGE(PG8_SA(0, 0), cA, voffA); PG8_STAGE(PG8_SB(0, 1), cB + hstepB, voffB); PG8_STAGE(PG8_SA(0, 1), cA + hstepA, voffA);
        if (wr == 1) PG8_BAR;
        PG8_WAIT_V(4); PG8_BAR;
        PG8_STAGE(PG8_SB(1, 0), cB + kstep, voffB); PG8_STAGE(PG8_SA(1, 0), cA + kstep, voffA); PG8_STAGE(PG8_SB(1, 1), cB + hstepB + kstep, voffB);
        PG8_WAIT_V(6); PG8_BAR;
    }
    bool has_next = false; int hq = 0; unsigned pend = 0u; Unit nn;
    if constexpr (Sched::DYN) { has_next = S.next(1, nxt); hq = (int)(__builtin_amdgcn_s_getreg((3 << 11) | 20) & (NXCD - 1)); }
    for (;;) {
        if constexpr (!Sched::DYN) has_next = S.next(ui + 1, nxt);
        const GAS char* nA = has_next ? PG8_ABASE(nxt) : cA; const GAS char* nB = has_next ? (const GAS char*)g.Bt + (size_t)nxt.pn * tstepB : cB;
        for (int t = 0; t < nt; t += 2) {
            const bool last = (t == nt - 2);
            const GAS char* a1 = cA + (size_t)(t + 1) * kstep;
            const GAS char* a2 = last ? nA : cA + (size_t)(t + 2) * kstep; const GAS char* b2 = last ? nB : cB + (size_t)(t + 2) * kstep;
            const GAS char* a3 = a2 + kstep; const GAS char* b3 = b2 + kstep;
            if constexpr (SP2) {
            PG8_LDB(B0, 0, 0); PG8_LDB(B1, 0, 1); PG8_SCHED; PG8_LDA(At, 0, 0); PG8_STAGE(PG8_SA(1, 1), a1 + hstepA, voffA);
            PG8_WAIT_V(8); PG8_WAIT_L(0); PG8_BAR; PG8_MMA(0, 0, At, B0); PG8_MMA(0, 1, At, B1); PG8_BAR; PG8_SCHED;
            PG8_LDA(At, 0, 1); PG8_STAGE(PG8_SB(0, 0), b2, voffB); PG8_STAGE(PG8_SB(0, 1), b2 + hstepB, voffB); PG8_STAGE(PG8_SA(0, 0), a2, voffA);
            PG8_WAIT_V(8); PG8_WAIT_L(0); PG8_BAR; PG8_MMA(1, 0, At, B0); PG8_MMA(1, 1, At, B1); PG8_BAR; PG8_SCHED;
            PG8_LDB(B0, 1, 0); PG8_LDB(B1, 1, 1); PG8_SCHED; PG8_LDA(At, 1, 0); PG8_STAGE(PG8_SA(0, 1), a2 + hstepA, voffA);
            PG8_WAIT_V(8); PG8_WAIT_L(0); PG8_BAR; PG8_MMA(0, 0, At, B0); PG8_MMA(0, 1, At, B1); PG8_BAR; PG8_SCHED;
            PG8_LDA(At, 1, 1); PG8_STAGE(PG8_SB(1, 0), b3, voffB); PG8_STAGE(PG8_SB(1, 1), b3 + hstepB, voffB); PG8_STAGE(PG8_SA(1, 0), a3, voffA);
            PG8_WAIT_V(8); PG8_WAIT_L(0); PG8_BAR; PG8_MMA(1, 0, At, B0); PG8_MMA(1, 1, At, B1); PG8_BAR; PG8_SCHED;
                    } else {
            PG8_LDB(B0, 0, 0); PG8_SCHED; PG8_LDA(At, 0, 0); PG8_STAGE(PG8_SA(1, 1), a1 + hstepA, voffA);
            PG8_WAIT_L(8); PG8_BAR; PG8_WAIT_L(0); PG8_MMA(0, 0, At, B0); PG8_BAR; PG8_SCHED;
            PG8_LDB(B1, 0, 1); PG8_STAGE(PG8_SB(0, 0), b2, voffB);
            PG8_BAR; PG8_WAIT_L(0); PG8_MMA(0, 1, At, B1); PG8_BAR;
            PG8_LDA(At, 0, 1); PG8_STAGE(PG8_SA(0, 0), a2, voffA);
            PG8_BAR; PG8_WAIT_L(0); PG8_MMA(1, 0, At, B0); PG8_BAR; PG8_SCHED;
            PG8_STAGE(PG8_SB(0, 1), b2 + hstepB, voffB);
            PG8_WAIT_V(6); PG8_BAR; PG8_MMA(1, 1, At, B1); PG8_BAR;
            PG8_LDB(B0, 1, 0); PG8_SCHED; PG8_LDA(At, 1, 0); PG8_STAGE(PG8_SA(0, 1), a2 + hstepA, voffA);
            PG8_WAIT_L(8); PG8_BAR; PG8_WAIT_L(0); PG8_MMA(0, 0, At, B0); PG8_BAR; PG8_SCHED;
            PG8_LDB(B1, 1, 1); PG8_STAGE(PG8_SB(1, 0), b3, voffB);
            PG8_BAR; PG8_WAIT_L(0); PG8_MMA(0, 1, At, B1); PG8_BAR;
            PG8_LDA(At, 1, 1); PG8_STAGE(PG8_SA(1, 0), a3, voffA);
            PG8_BAR; PG8_WAIT_L(0); PG8_MMA(1, 0, At, B0); PG8_BAR; PG8_SCHED;
            PG8_STAGE(PG8_SB(1, 1), b3 + hstepB, voffB);
            PG8_WAIT_V(6); PG8_BAR; PG8_MMA(1, 1, At, B1); PG8_BAR;
            }
        }
        if constexpr (ALIGN_EPI) { if (wr == 0) PG8_BAR; }
        if constexpr (Sched::DYN) { if (has_next) pend = S.issue(tid, hq); }
        E(acc, cur, wr, wc, fr, fq);
        if (!has_next) break;
        bool has_nn = false;
        if constexpr (Sched::DYN) has_nn = S.resolve(tid, pend, hq, nn);
#pragma unroll
        for (int a = 0; a < 2; ++a)
#pragma unroll
            for (int b = 0; b < 2; ++b)
#pragma unroll
                for (int m = 0; m < 4; ++m)
#pragma unroll
                    for (int n = 0; n < 2; ++n) acc[a][b][m][n] = (f32x4){0.f, 0.f, 0.f, 0.f};
        cur = nxt; cA = nA; cB = nB; ++ui;
        if constexpr (Sched::DYN) { nxt = nn; has_next = has_nn; }
        if constexpr (ALIGN_EPI) { if (wr == 1) PG8_BAR; }
    }
    PG8_WAIT_V(0);
    if constexpr (!ALIGN_EPI) { if (wr == 0) PG8_BAR; }
    PG8_BAR;
#undef PG8_ABASE
#undef PG8_SA
#undef PG8_SB
#undef PG8_STAGE
#undef PG8_LDA
#undef PG8_LDB
#undef PG8_MMA
#undef PG8_WAIT_V
#undef PG8_WAIT_L
#undef PG8_BAR
#undef PG8_SCHED
}
}

constexpr int NWAVES = 8;
constexpr int D = 2048, NB = 16, SEQ = 2048, CTXL = 256, DEPTH = 4, DFF = 5632, NGU = 2 * DFF, NQKV = 2560, KVD = 256, HD = 64, NHEAD = 32, NKVH = 4;
constexpr int ML = NB * SEQ, MC = NB * CTXL, MT = ML + MC;
constexpr int NADA = 6 * D;
constexpr float RMS_EPS = 1e-6f;

constexpr size_t MiB = 1u << 20;
constexpr size_t WS_CTL = 0, CTL_ZERO_BYTES = 1 * MiB;
constexpr size_t WS_ADA = 1 * MiB;
constexpr size_t WS_ROPE = 5 * MiB;
constexpr size_t WS_Y2 = 6 * MiB;
constexpr size_t WS_XB = 1026 * MiB;
constexpr size_t WS_H = 38 * MiB;
constexpr size_t WS_Y = 182 * MiB;
constexpr size_t WS_ACT = 326 * MiB;
constexpr size_t WS_Q = 326 * MiB, WS_K = 470 * MiB, WS_V = 488 * MiB, WS_O = 506 * MiB, WS_P = 326 * MiB;
constexpr size_t WS_WGU = 722 * MiB, WS_WD = 898 * MiB, WS_WQKV = 986 * MiB, WS_WO = 1006 * MiB, WS_WP = 1022 * MiB, WS_END = 1170 * MiB;
static_assert(WS_ACT + (size_t)MT * DFF * 2 <= WS_WGU && WS_O + (size_t)MT * D * 2 <= WS_WGU && WS_Y + (size_t)MT * D * 2 <= WS_ACT && WS_H + (size_t)MT * D * 2 <= WS_Y, "d_ws map");
static_assert(WS_WGU + (size_t)DEPTH * NGU * D * 2 <= WS_WD && WS_WD + (size_t)DEPTH * D * DFF * 2 <= WS_WQKV && WS_WQKV + (size_t)2 * NQKV * D * 2 <= WS_WO && WS_WO + (size_t)2 * D * D * 2 <= WS_WP && WS_WP + (size_t)2 * D * 512 * 2 <= WS_XB && WS_XB + (size_t)MT * D * 2 <= WS_END, "d_ws weights");
constexpr int CW_BAR = 4096;
constexpr int CW_FA = 32768 + 1024;
constexpr int CW_FQ = 32768;
constexpr int CW_DQ = 65536;

constexpr int LDS_BYTES = 147456;
constexpr int LDSCTL_OFF = LDS_BYTES - 512;
constexpr int MISC_OFF = LDSCTL_OFF + 64;

typedef unsigned short bf16;
typedef unsigned v4u __attribute__((ext_vector_type(4)));
typedef unsigned v2u __attribute__((ext_vector_type(2)));
typedef float f32x4 __attribute__((ext_vector_type(4)));
typedef float f32x16 __attribute__((ext_vector_type(16)));
typedef short bf16x8 __attribute__((ext_vector_type(8)));
typedef short s16x4 __attribute__((ext_vector_type(4)));
typedef GAS unsigned gu32;
typedef GAS float gf32; typedef const GAS float cgf32; typedef GAS bf16 gb16; typedef const GAS bf16 cgb16;
#define RLX_AGENT __ATOMIC_RELAXED, __HIP_MEMORY_SCOPE_AGENT
#define LDS_WAIT() asm volatile("s_waitcnt lgkmcnt(0)" ::: "memory")
using pg8::cvtpk;

#define XB_TMO      128
#define XB_XCNT(j)  (256  + 64 * (j))
#define XB_XSUB(j)  (1280 + 64 * (j))
#define XB_XGEN(j)  (2304 + 64 * (j))
#define XB_TOP      3328
#define XB_TOPGEN   3392
#define XCD_BAR_WORDS 3456
#define XB_SPIN_CAP (1u << 18)

__device__ __forceinline__ unsigned xb_ld(unsigned* p)              { return __hip_atomic_load(p, __ATOMIC_RELAXED, __HIP_MEMORY_SCOPE_AGENT); }
__device__ __forceinline__ unsigned xb_add(unsigned* p, unsigned v) { return __hip_atomic_fetch_add(p, v, __ATOMIC_RELAXED, __HIP_MEMORY_SCOPE_AGENT); }
__device__ __forceinline__ unsigned xb_xcc_id() { return (unsigned)__builtin_amdgcn_s_getreg((3 << 11) | 20) & 0xFu; }
#define XB_SPIN(cond, bar) do { unsigned _sp = 0; while (cond) { __builtin_amdgcn_s_sleep(1); \
    if ((++_sp & 255u) == 0u) { if (xb_ld(&(bar)[XB_TMO])) break; if (_sp > XB_SPIN_CAP) { atomicAdd(&(bar)[XB_TMO], 1u); break; } } } } while (0)

struct XcdBarrier { unsigned* bar; unsigned x; volatile LAS unsigned* st; };

__device__ __forceinline__ XcdBarrier xcd_barrier_post(unsigned* bar, volatile LAS unsigned* st) {
    XcdBarrier b; b.bar = bar; b.x = xb_xcc_id(); b.st = st;
    if (threadIdx.x == 0) (void)xb_add(&bar[XB_XCNT(b.x)], 1u);
    return b;
}
__device__ __forceinline__ void xcd_barrier_complete(unsigned* bar, unsigned x, unsigned& nloc, unsigned& nx) {
    const unsigned G = gridDim.x * gridDim.y * gridDim.z;
    unsigned sum, cnt, mine, sp = 0u;
    for (;;) {
        sum = 0u; cnt = 0u; mine = 0u;
#pragma unroll
        for (unsigned j = 0; j < 16; ++j) { const unsigned c = xb_ld(&bar[XB_XCNT(j)]); sum += c; cnt += (c > 0u) ? 1u : 0u; mine = (j == x) ? c : mine; }
        if (sum == G) break;
        __builtin_amdgcn_s_sleep(1);
        if ((++sp & 255u) == 0u) { if (xb_ld(&bar[XB_TMO])) break; if (sp > XB_SPIN_CAP) { atomicAdd(&bar[XB_TMO], 1u); break; } }
    }
    nloc = mine > 0u ? mine : 1u; nx = cnt > 0u ? cnt : 1u;
}
__device__ __forceinline__ void xcd_barrier(const XcdBarrier& b) {
    asm volatile("s_waitcnt vmcnt(0)" ::: "memory");
    __syncthreads();
    if (threadIdx.x == 0) {
        unsigned* bar = b.bar;
        __builtin_amdgcn_s_waitcnt(0);
        unsigned nloc = b.st[0], nx = b.st[1];
        if (nloc == 0u) { xcd_barrier_complete(bar, b.x, nloc, nx); b.st[0] = nloc; b.st[1] = nx; }
        const unsigned old = xb_add(&bar[XB_XSUB(b.x)], 1u);
        const unsigned gen = old / nloc;
        if (old + 1u == (gen + 1u) * nloc) {
            __builtin_amdgcn_fence(__ATOMIC_RELEASE, "agent");
            asm volatile("s_waitcnt vmcnt(0)" ::: "memory");
            const unsigned og = xb_add(&bar[XB_TOP], 1u);
            const unsigned tg = og / nx;
            if (og + 1u == (tg + 1u) * nx) xb_add(&bar[XB_TOPGEN], 1u);
            else XB_SPIN(xb_ld(&bar[XB_TOPGEN]) == tg, bar);
            __builtin_amdgcn_fence(__ATOMIC_ACQUIRE, "agent");
            xb_add(&bar[XB_XGEN(b.x)], 1u);
            asm volatile("s_waitcnt vmcnt(0)" ::: "memory");
        } else {
            XB_SPIN(xb_ld(&bar[XB_XGEN(b.x)]) == gen, bar);
            __builtin_amdgcn_fence(__ATOMIC_ACQUIRE, "agent");
            asm volatile("s_waitcnt vmcnt(0)" ::: "memory");
        }
    }
    __syncthreads();
}

struct Args { const float* in[17]; float* out; unsigned char* ws; int ph_lo, ph_hi; };
#define GIN(k) ((cgf32*)args.in[k])
struct Frame {
    LAS unsigned char* lds;
    volatile LAS unsigned* MISC;
    gu32* ctl;
    int tid, lane, wave, vcu, G, bx;
    GAS unsigned char* ws;
};

__device__ __forceinline__ float wave_sum(float v) {
#define WS_DPP(ctrl) v += __int_as_float(__builtin_amdgcn_update_dpp(0, __float_as_int(v), (ctrl), 0xF, 0xF, true))
    WS_DPP(0xB1); WS_DPP(0x4E); WS_DPP(0x141); WS_DPP(0x140);
#undef WS_DPP
    const float a = __int_as_float(__builtin_amdgcn_readlane(__float_as_int(v), 0)), b = __int_as_float(__builtin_amdgcn_readlane(__float_as_int(v), 16));
    const float c = __int_as_float(__builtin_amdgcn_readlane(__float_as_int(v), 32)), d = __int_as_float(__builtin_amdgcn_readlane(__float_as_int(v), 48));
    return (a + b) + (c + d);
}

__device__ __forceinline__ void p0_transpose_item(cgf32* W, int ldw, gb16* WT, int ldk, int k0, int n0, int drow0, LAS float* scr, int lane) {
    f32x4 v[16];
#pragma unroll
    for (int i = 0; i < 16; ++i) v[i] = __builtin_nontemporal_load((const GAS f32x4*)(W + (size_t)(k0 + 4 * i + (lane >> 4)) * ldw + n0 + 4 * (lane & 15)));
#pragma unroll
    for (int i = 0; i < 16; ++i) { LAS float* d = scr + (4 * i + (lane >> 4)) * 65 + 4 * (lane & 15); d[0] = v[i].x; d[1] = v[i].y; d[2] = v[i].z; d[3] = v[i].w; }
    LDS_WAIT(); asm volatile("" ::: "memory");
    const int c = lane & 7;
#pragma unroll
    for (int j = 0; j < 8; ++j) { const int n = (lane >> 3) + 8 * j; const LAS float* s = scr + (8 * c) * 65 + n;
        v4u o; o.x = cvtpk(s[0 * 65], s[1 * 65]); o.y = cvtpk(s[2 * 65], s[3 * 65]); o.z = cvtpk(s[4 * 65], s[5 * 65]); o.w = cvtpk(s[6 * 65], s[7 * 65]);
        __builtin_nontemporal_store(o, (GAS v4u*)(WT + (size_t)(drow0 + n) * ldk + k0 + 8 * c)); }
    LDS_WAIT(); asm volatile("" ::: "memory");
}

__device__ __forceinline__ void p0_transpose_item_scaled(cgf32* W, int ldw, gb16* WT, int ldk, int k0, int n0, int drow0, LAS float* scr, int lane, cgf32* rs) {
    f32x4 v[16]; float f[8];
#pragma unroll
    for (int i = 0; i < 16; ++i) v[i] = __builtin_nontemporal_load((const GAS f32x4*)(W + (size_t)(k0 + 4 * i + (lane >> 4)) * ldw + n0 + 4 * (lane & 15)));
#pragma unroll
    for (int j = 0; j < 8; ++j) f[j] = rs[n0 + (lane >> 3) + 8 * j];
#pragma unroll
    for (int i = 0; i < 16; ++i) { LAS float* d = scr + (4 * i + (lane >> 4)) * 65 + 4 * (lane & 15); d[0] = v[i].x; d[1] = v[i].y; d[2] = v[i].z; d[3] = v[i].w; }
    LDS_WAIT(); asm volatile("" ::: "memory");
    const int c = lane & 7;
#pragma unroll
    for (int j = 0; j < 8; ++j) { const int n = (lane >> 3) + 8 * j; const LAS float* s = scr + (8 * c) * 65 + n; const float g = f[j];
        v4u o; o.x = cvtpk(s[0 * 65] * g, s[1 * 65] * g); o.y = cvtpk(s[2 * 65] * g, s[3 * 65] * g); o.z = cvtpk(s[4 * 65] * g, s[5 * 65] * g); o.w = cvtpk(s[6 * 65] * g, s[7 * 65] * g);
        __builtin_nontemporal_store(o, (GAS v4u*)(WT + (size_t)(drow0 + n) * ldk + k0 + 8 * c)); }
    LDS_WAIT(); asm volatile("" ::: "memory");
}

constexpr int I_GU = (D / 64) * (NGU / 64), I_D = (DFF / 64) * (D / 64), I_QKV = (D / 64) * (NQKV / 64), I_O = (D / 64) * (D / 64), I_P = (512 / 64) * (512 / 64);
__device__ __forceinline__ int conv_count(int l) { return I_GU + I_D + ((l & 1) ? I_QKV + I_O : 4 * I_P); }
__device__ __forceinline__ void conv_layer_item(const Args& args, GAS unsigned char* ws, int l, int r, LAS float* scr, int lane) {
    if (r < I_GU) { const int q = r, nblk = NGU / 64, k0 = 64 * (q / nblk), n0 = 64 * (q % nblk);
        const int nn = n0 < DFF ? n0 : n0 - DFF, drow = (nn >> 7) * 256 + (n0 < DFF ? 0 : 128) + (nn & 127);
        p0_transpose_item(GIN(15) + (size_t)l * D * NGU, NGU, (gb16*)(ws + WS_WGU) + (size_t)l * NGU * D, D, k0, n0, drow, scr, lane); return; } r -= I_GU;
    if (r < I_D) { const int q = r, nblk = D / 64, k0 = 64 * (q / nblk), n0 = 64 * (q % nblk);
        p0_transpose_item(GIN(16) + (size_t)l * DFF * D, D, (gb16*)(ws + WS_WD) + (size_t)l * D * DFF, DFF, k0, n0, n0, scr, lane); return; } r -= I_D;
    const int j = l >> 1;
    if (l & 1) {
        if (r < I_QKV) { const int q = r, nblk = NQKV / 64, k0 = 64 * (q / nblk), n0 = 64 * (q % nblk);
            p0_transpose_item(GIN(12) + (size_t)j * D * NQKV, NQKV, (gb16*)(ws + WS_WQKV) + (size_t)j * NQKV * D, D, k0, n0, n0, scr, lane); return; } r -= I_QKV;
        { const int q = r, nblk = D / 64, k0 = 64 * (q / nblk), n0 = 64 * (q % nblk);
            p0_transpose_item(GIN(13) + (size_t)j * D * D, D, (gb16*)(ws + WS_WO) + (size_t)j * D * D, D, k0, n0, n0, scr, lane); }
    } else { const int jg = 4 * j + r / I_P, q = r % I_P, nblk = 512 / 64, k0 = 64 * (q / nblk), n0 = 64 * (q % nblk);
        p0_transpose_item_scaled(GIN(10) + (size_t)jg * 512 * 512, 512, (gb16*)(ws + WS_WP) + (size_t)jg * 512 * 512, 512, k0, n0, n0, scr, lane, GIN(11) + (size_t)jg * 512); }
}
__device__ __forceinline__ bool conv_batch(const Args& args, GAS unsigned char* ws, LAS unsigned char* lds, int l, int batch, int tid) {
    const int wave = __builtin_amdgcn_readfirstlane(tid >> 6), r = batch * NWAVES + wave;
    if (r < conv_count(l)) conv_layer_item(args, ws, l, r, (LAS float*)(lds + wave * 16896), tid & 63);
    return true;
}
__device__ __forceinline__ void conv_drain(const Args& args, GAS unsigned char* ws, LAS unsigned char* lds, int l, int tid) {
    volatile LAS int* st = (volatile LAS int*)(lds + MISC_OFF) + 40;
    const int nb = (conv_count(l) + NWAVES - 1) / NWAVES;
    GAS unsigned* q = (GAS unsigned*)(ws + WS_CTL) + CW_FQ + 64 * l;
    unsigned nxt = 0u;
    if (tid == 0) nxt = __hip_atomic_fetch_add(q, 1u, RLX_AGENT);
    for (;;) {
        __syncthreads();
        if (tid == 0) st[0] = (int)nxt;
        __syncthreads();
        const int b = __builtin_amdgcn_readfirstlane(st[0]);
        if (b >= nb) break;
        if (tid == 0) nxt = __hip_atomic_fetch_add(q, 1u, RLX_AGENT);
        conv_batch(args, ws, lds, l, b, tid);
    }
    __syncthreads();
}
__device__ __forceinline__ void xcd_barrier_fill(const XcdBarrier& b, const Args& args, GAS unsigned char* ws, LAS unsigned char* lds, int fl, int nf, int tid) {
    volatile LAS int* st = (volatile LAS int*)(lds + MISC_OFF) + 40;
    asm volatile("s_waitcnt vmcnt(0)" ::: "memory");
    __syncthreads();
    if (tid == 0) {
        unsigned* bar = b.bar;
        __builtin_amdgcn_s_waitcnt(0);
        unsigned nloc = b.st[0], nx = b.st[1];
        if (nloc == 0u) { xcd_barrier_complete(bar, b.x, nloc, nx); b.st[0] = nloc; b.st[1] = nx; }
        (void)__hip_atomic_fetch_add((GAS unsigned*)(ws + WS_CTL) + CW_FA, 1u, RLX_AGENT);
        const unsigned old = xb_add(&bar[XB_XSUB(b.x)], 1u);
        const unsigned gen = old / nloc;
        if (old + 1u == (gen + 1u) * nloc) {
            __builtin_amdgcn_fence(__ATOMIC_RELEASE, "agent");
            asm volatile("s_waitcnt vmcnt(0)" ::: "memory");
            const unsigned og = xb_add(&bar[XB_TOP], 1u);
            const unsigned tg = og / nx;
            if (og + 1u == (tg + 1u) * nx) xb_add(&bar[XB_TOPGEN], 1u);
            else XB_SPIN(xb_ld(&bar[XB_TOPGEN]) == tg, bar);
            __builtin_amdgcn_fence(__ATOMIC_ACQUIRE, "agent");
            xb_add(&bar[XB_XGEN(b.x)], 1u);
            asm volatile("s_waitcnt vmcnt(0)" ::: "memory");
            st[1] = 1;
        } else { st[1] = 0; st[2] = (int)gen; }
    }
    __syncthreads();
    if (st[1] == 0) {
        const int nb = (conv_count(fl) + NWAVES - 1) / NWAVES;
        bool dry = false; unsigned sp = 0u;
        for (;;) {
            if (tid == 0) {
                unsigned* bar = b.bar;
                int code = -1;
                const bool rel = xb_ld(&bar[XB_XGEN(b.x)]) != (unsigned)st[2] || ((++sp & 1023u) == 0u && xb_ld(&bar[XB_TMO]) != 0u);
                if (!rel && !dry) {
                    const unsigned G = gridDim.x, arr = __hip_atomic_load((GAS unsigned*)(ws + WS_CTL) + CW_FA, RLX_AGENT);
                    if (arr - (unsigned)nf * G < G - FILL_STOP) code = (int)__hip_atomic_fetch_add((GAS unsigned*)(ws + WS_CTL) + CW_FQ + 64 * fl, 1u, RLX_AGENT);
                }
                st[0] = code; st[1] = rel ? 1 : 0;
            }
            __syncthreads();
            const int code = __builtin_amdgcn_readfirstlane(st[0]); const int rel = __builtin_amdgcn_readfirstlane(st[1]);
            if (rel) break;
            if (code >= 0 && code < nb) conv_batch(args, ws, lds, fl, code, tid);
            else { if (code >= nb) dry = true; __builtin_amdgcn_s_sleep(2); }
            __syncthreads();
        }
        if (tid == 0) { __builtin_amdgcn_fence(__ATOMIC_ACQUIRE, "agent"); asm volatile("s_waitcnt vmcnt(0)" ::: "memory"); }
    }
    __syncthreads();
}

__device__ __forceinline__ void p0_prologue(Frame& F, const Args& args) {
    GAS unsigned char* ws = F.ws;
    if (F.bx == 0) { for (int e = F.tid; e < 64 * 16; e += NWAVES * 64) { const int pos = e >> 4, i = e & 15;
        const float inv = 1.0f / __builtin_powf(10000.0f, (float)(2 * i) / 32.0f); const float ang = (float)pos * inv;
        gf32* t = (gf32*)(ws + WS_ROPE) + 2 * e; t[0] = __builtin_cosf(ang); t[1] = __builtin_sinf(ang); } }
    {
        LAS float* S = (LAS float*)F.lds;
        cgf32* cin = GIN(1); cgf32* cctx = GIN(3); cgf32* w_ada = GIN(4); cgf32* b_ada = GIN(5); gf32* ada = (gf32*)(ws + WS_ADA);
        for (int cb = F.bx; cb < (DEPTH * NADA) / 256; cb += F.G) {
            __syncthreads();
            for (int k = F.tid; k < D; k += NWAVES * 64) {
                float v[17];
#pragma unroll
                for (int b = 0; b < 16; ++b) v[b] = cin[b * D + k];
                v[16] = cctx[k];
                __builtin_amdgcn_sched_barrier(0);
#pragma unroll
                for (int b = 0; b < 17; ++b) S[k * 17 + b] = v[b] / (1.0f + __expf(-v[b]));
            }
            __syncthreads();
            const int l = cb / (NADA / 256), cblk = cb % (NADA / 256), col = cblk * 256 + 4 * F.lane;
            cgf32* W = w_ada + (size_t)l * D * NADA + col;
            f32x4 acc[17];
#pragma unroll
            for (int b = 0; b < 17; ++b) acc[b] = (f32x4){0.f, 0.f, 0.f, 0.f};
            const int k0 = F.wave * 256;
            f32x4 w[8];
#pragma unroll
            for (int u = 0; u < 8; ++u) w[u] = __builtin_nontemporal_load((const GAS f32x4*)(W + (size_t)(k0 + u) * NADA));
            for (int kk = 0; kk < 256; kk += 8) {
                f32x4 wn[8]; const int kn = kk + 8 < 256 ? kk + 8 : kk;
#pragma unroll
                for (int u = 0; u < 8; ++u) wn[u] = __builtin_nontemporal_load((const GAS f32x4*)(W + (size_t)(k0 + kn + u) * NADA));
                __builtin_amdgcn_sched_barrier(0);
#pragma unroll
                for (int u = 0; u < 8; ++u) { const LAS float* sp = S + (k0 + kk + u) * 17;
#pragma unroll
                    for (int b = 0; b < 17; ++b) acc[b] += sp[b] * w[u]; }
                __builtin_amdgcn_sched_barrier(0);
#pragma unroll
                for (int u = 0; u < 8; ++u) w[u] = wn[u];
            }
            __syncthreads();
#pragma unroll
            for (int b = 0; b < 17; ++b) *(LAS f32x4*)(S + ((F.wave * 17 + b) * 256 + 4 * F.lane)) = acc[b];
            __syncthreads();
            const float bias = b_ada[l * NADA + cblk * 256 + (F.tid & 255)];
            for (int o = F.tid; o < 17 * 256; o += NWAVES * 64) { const int b = o >> 8, c = o & 255; float s = bias;
#pragma unroll
                for (int w = 0; w < 8; ++w) s += S[(w * 17 + b) * 256 + c];
                ada[(size_t)(l * 17 + b) * NADA + cblk * 256 + c] = s; }
        }
        __syncthreads();
    }
    conv_drain(args, ws, F.lds, 0, F.tid);
}

struct ThinVec { cgf32* adaG; cgf32* wpost; cgf32* adaSc; cgf32* adaSh; cgf32* wpre; };
struct ThinIO { cgf32* xsL; cgf32* xsC; cgb16* xsB; gf32* xdL; gf32* xdC; gb16* xdB; cgb16* Y; cgb16* Y2; gb16* H; bool src_bf, dst_bf, write_h; };
__device__ __forceinline__ f32x4 bf4_to_f(const v2u v) { return (f32x4){__uint_as_float(v.x << 16), __uint_as_float(v.x & 0xffff0000u), __uint_as_float(v.y << 16), __uint_as_float(v.y & 0xffff0000u)}; }
template <bool HAS_Y>
__device__ __forceinline__ void thin_load_row(int r, const ThinIO& io, int lc, f32x4 (&x)[8], v2u (&xr)[8], v2u (&yr)[8], v2u (&y2r)[8]) {
    if (io.src_bf) {
#pragma unroll
        for (int j = 0; j < 8; ++j) xr[j] = __builtin_nontemporal_load((const GAS v2u*)(io.xsB + (size_t)r * D + 256 * j + lc));
    } else {
        cgf32* xs = r < ML ? io.xsL + (size_t)r * D : io.xsC + (size_t)(r - ML) * D;
#pragma unroll
        for (int j = 0; j < 8; ++j) x[j] = __builtin_nontemporal_load((const GAS f32x4*)(xs + 256 * j + lc));
    }
    if (HAS_Y) {
#pragma unroll
        for (int j = 0; j < 8; ++j) yr[j] = __builtin_nontemporal_load((const GAS v2u*)(io.Y + (size_t)r * D + 256 * j + lc));
        if (r >= ML) {
#pragma unroll
            for (int j = 0; j < 8; ++j) y2r[j] = __builtin_nontemporal_load((const GAS v2u*)(io.Y2 + (size_t)(r - ML) * D + 256 * j + lc)); }
    }
}
template <bool HAS_Y>
__device__ __forceinline__ void thin_proc_row(int r, const ThinIO& io, const LAS float* vec, int lc, f32x4 (&x)[8], const v2u (&xr)[8], const v2u (&yr)[8], const v2u (&y2r)[8]) {
    if (io.src_bf) {
#pragma unroll
        for (int j = 0; j < 8; ++j) x[j] = bf4_to_f(xr[j]);
    }
    if (HAS_Y) {
        f32x4 y[8]; float ss = 0.f;
#pragma unroll
        for (int j = 0; j < 8; ++j) { y[j] = bf4_to_f(yr[j]); if (r >= ML) y[j] += bf4_to_f(y2r[j]);
            ss += (y[j].x * y[j].x + y[j].y * y[j].y) + (y[j].z * y[j].z + y[j].w * y[j].w); }
        f32x4 gp[8];
#pragma unroll
        for (int j = 0; j < 8; ++j) gp[j] = *(const LAS f32x4*)(vec + 256 * j + lc);
        const float ry = 1.0f / sqrtf(wave_sum(ss) * (1.0f / D) + RMS_EPS);
#pragma unroll
        for (int j = 0; j < 8; ++j) x[j] += gp[j] * (y[j] * ry);
        if (io.dst_bf) {
#pragma unroll
            for (int j = 0; j < 8; ++j) { v2u o; o.x = cvtpk(x[j].x, x[j].y); o.y = cvtpk(x[j].z, x[j].w); __builtin_nontemporal_store(o, (GAS v2u*)(io.xdB + (size_t)r * D + 256 * j + lc)); x[j] = bf4_to_f(o); }
        } else {
            gf32* xd = r < ML ? io.xdL + (size_t)r * D : io.xdC + (size_t)(r - ML) * D;
#pragma unroll
            for (int j = 0; j < 8; ++j) __builtin_nontemporal_store(x[j], (GAS f32x4*)(xd + 256 * j + lc));
        }
    }
    if (io.write_h) {
        float ss = 0.f;
#pragma unroll
        for (int j = 0; j < 8; ++j) ss += (x[j].x * x[j].x + x[j].y * x[j].y) + (x[j].z * x[j].z + x[j].w * x[j].w);
        f32x4 wm[8];
#pragma unroll
        for (int j = 0; j < 8; ++j) wm[j] = *(const LAS f32x4*)(vec + D + 256 * j + lc);
        const float rx = 1.0f / sqrtf(wave_sum(ss) * (1.0f / D) + RMS_EPS);
        f32x4 sh[8];
#pragma unroll
        for (int j = 0; j < 8; ++j) sh[j] = *(const LAS f32x4*)(vec + 2 * D + 256 * j + lc);
#pragma unroll
        for (int j = 0; j < 8; ++j) { const f32x4 h = (x[j] * rx) * wm[j] + sh[j]; v2u o; o.x = cvtpk(h.x, h.y); o.y = cvtpk(h.z, h.w); *(GAS v2u*)(io.H + (size_t)r * D + 256 * j + lc) = o; }
    }
}
template <bool HAS_Y>
__device__ __forceinline__ void thin_phase(Frame& F, int M, const ThinIO io, const ThinVec tv) {
    const int NGW = F.G * NWAVES, gw = F.vcu * NWAVES + F.wave;
    const int rpl = (ML + NGW - 1) / NGW, l0 = gw * rpl < ML ? gw * rpl : ML, nl = (l0 + rpl < ML ? l0 + rpl : ML) - l0;
    const int Mc = M - ML, rpc = (Mc + NGW - 1) / NGW, c0r = gw * rpc < Mc ? gw * rpc : Mc, nc = (c0r + rpc < Mc ? c0r + rpc : Mc) - c0r, c0 = ML + c0r, nrow = nl + nc;
    const int wl0 = F.vcu * NWAVES * rpl < ML ? F.vcu * NWAVES * rpl : ML - 1, wl1 = (F.vcu * NWAVES + NWAVES) * rpl - 1 < ML ? (F.vcu * NWAVES + NWAVES) * rpl - 1 : ML - 1;
    const int bA = wl0 >> 11, bB = wl1 >> 11;
    LAS float* V = (LAS float*)F.lds;
    const int lc = 4 * F.lane;
    f32x4 xa[8], xb[8]; v2u xra[8], xrb[8], ya[8], yb[8], y2a[8], y2b[8];
#define THIN_ROW(i) ((i) < nl ? l0 + (i) : c0 + ((i) - nl))
#define THIN_VEC(r) (V + ((r) >= ML ? 6 * D : (((r) >> 11) != bA ? 3 * D : 0)))
    if (nrow > 0) thin_load_row<HAS_Y>(THIN_ROW(0), io, lc, xa, xra, ya, y2a);
    static_assert(3 * D == 12 * NWAVES * 64, "vector staging: 12 elements per thread");
#pragma unroll
    for (int k0 = 0; k0 < 12; k0 += 6) {
        float vg[6], vp[6], vr[6], vs[6], vh[6];
#pragma unroll
        for (int k = 0; k < 6; ++k) { const int e = F.tid + (k0 + k) * NWAVES * 64, sl = e >> 11, c = e & (D - 1), b = sl == 0 ? bA : (sl == 1 ? bB : 16);
            if (HAS_Y) { vg[k] = tv.adaG[(size_t)b * NADA + c]; vp[k] = tv.wpost[c]; }
            vr[k] = tv.wpre[c]; vs[k] = tv.adaSc[(size_t)b * NADA + c]; vh[k] = tv.adaSh[(size_t)b * NADA + c]; }
        __builtin_amdgcn_sched_barrier(0);
#pragma unroll
        for (int k = 0; k < 6; ++k) { const int e = F.tid + (k0 + k) * NWAVES * 64, sl = e >> 11, c = e & (D - 1);
            if (HAS_Y) V[sl * 3 * D + c] = vg[k] * vp[k];
            V[sl * 3 * D + D + c] = vr[k] * (1.0f + vs[k]); V[sl * 3 * D + 2 * D + c] = vh[k]; }
    }
    __syncthreads();
    for (int i = 0; i < nrow; i += 2) {
        if (i + 1 < nrow) thin_load_row<HAS_Y>(THIN_ROW(i + 1), io, lc, xb, xrb, yb, y2b);
        { const int r = THIN_ROW(i); thin_proc_row<HAS_Y>(r, io, THIN_VEC(r), lc, xa, xra, ya, y2a); }
        if (i + 1 < nrow) {
            if (i + 2 < nrow) thin_load_row<HAS_Y>(THIN_ROW(i + 2), io, lc, xa, xra, ya, y2a);
            const int r = THIN_ROW(i + 1); thin_proc_row<HAS_Y>(r, io, THIN_VEC(r), lc, xb, xrb, yb, y2b);
        }
    }
#undef THIN_ROW
#undef THIN_VEC
    __syncthreads();
}

__device__ __forceinline__ void bf8_to_f(const v4u v, float (&f)[8]) {
    f[0] = __uint_as_float(v.x << 16); f[1] = __uint_as_float(v.x & 0xffff0000u); f[2] = __uint_as_float(v.y << 16); f[3] = __uint_as_float(v.y & 0xffff0000u);
    f[4] = __uint_as_float(v.z << 16); f[5] = __uint_as_float(v.z & 0xffff0000u); f[6] = __uint_as_float(v.w << 16); f[7] = __uint_as_float(v.w & 0xffff0000u);
}
template <int HALF>
__device__ __forceinline__ void pool_task(cgb16* Hs, gb16* Ps, const int t0, const int Ls, const int nrows) {
    constexpr int W = 8 + 2 * HALF;
    v4u win[W];
#define POOL_LD(t) (*(const GAS v4u*)(Hs + (size_t)((t) < 0 ? 0 : ((t) > Ls - 1 ? Ls - 1 : (t))) * D))
#pragma unroll
    for (int k = 0; k < W; ++k) win[k] = POOL_LD(t0 - HALF + k);
    float S[8];
#pragma unroll
    for (int e = 0; e < 8; ++e) S[e] = 0.f;
#pragma unroll
    for (int k = 0; k < 2 * HALF; ++k) { const int tt = t0 - HALF + k; const float m = (tt >= 0 && tt < Ls) ? 1.f : 0.f; float f[8]; bf8_to_f(win[k], f);
#pragma unroll
        for (int e = 0; e < 8; ++e) S[e] += m * f[e]; }
    for (int tb = t0; tb < t0 + nrows; tb += 8) {
        v4u nw[8];
#pragma unroll
        for (int j = 0; j < 8; ++j) nw[j] = (tb + 8 < t0 + nrows) ? POOL_LD(tb + 8 + HALF + j) : win[0];
        __builtin_amdgcn_sched_barrier(0);
#pragma unroll
        for (int i = 0; i < 8; ++i) { const int t = tb + i;
            const int lo = t - HALF > 0 ? t - HALF : 0, hi = t + HALF < Ls ? t + HALF : Ls; const float rc = 1.0f / (float)(hi - lo);
            float c[8]; bf8_to_f(win[HALF + i], c);
            v4u o; o.x = cvtpk(S[0] * rc - c[0], S[1] * rc - c[1]); o.y = cvtpk(S[2] * rc - c[2], S[3] * rc - c[3]); o.z = cvtpk(S[4] * rc - c[4], S[5] * rc - c[5]); o.w = cvtpk(S[6] * rc - c[6], S[7] * rc - c[7]);
            *(GAS v4u*)(Ps + (size_t)t * D) = o;
            const float ma = (t + HALF < Ls) ? 1.f : 0.f, ms = (t - HALF >= 0) ? 1.f : 0.f; float fa[8], fs[8]; bf8_to_f(win[2 * HALF + i], fa); bf8_to_f(win[i], fs);
#pragma unroll
            for (int e = 0; e < 8; ++e) S[e] += ma * fa[e] - ms * fs[e]; }
        __builtin_amdgcn_sched_barrier(0);
#pragma unroll
        for (int k = 0; k < 2 * HALF; ++k) win[k] = win[k + 8];
#pragma unroll
        for (int j = 0; j < 8; ++j) win[2 * HALF + j] = nw[j];
    }
#undef POOL_LD
}
__device__ __forceinline__ void pool_run(int lane, cgb16* H, gb16* P, int task, int roff, int nrows) {
    const int g = task & 3, r0 = (task >> 2) * 32 + roff;
    const int s0 = r0 < ML ? (r0 & ~(SEQ - 1)) : ML + ((r0 - ML) & ~(CTXL - 1)), Ls = r0 < ML ? SEQ : CTXL, t0 = r0 - s0;
    cgb16* Hs = H + (size_t)s0 * D + g * 512 + 8 * lane; gb16* Ps = P + (size_t)s0 * D + g * 512 + 8 * lane;
    if (g == 0) pool_task<1>(Hs, Ps, t0, Ls, nrows); else if (g == 1) pool_task<2>(Hs, Ps, t0, Ls, nrows); else if (g == 2) pool_task<4>(Hs, Ps, t0, Ls, nrows); else pool_task<8>(Hs, Ps, t0, Ls, nrows);
}
__device__ __forceinline__ void pool_phase(Frame& F, int M, cgb16* H, gb16* P) {
    const int NGW = F.G * NWAVES, gw = F.vcu * NWAVES + F.wave, ntask = (M / 32) * 4, nfull = (ntask / NGW) * NGW;
    for (int task = gw; task < nfull; task += NGW) pool_run(F.lane, H, P, task, 0, 32);
    for (int q = gw; q < (ntask - nfull) * 4; q += NGW) pool_run(F.lane, H, P, nfull + (q >> 2), 8 * (q & 3), 8);
}

namespace att {
constexpr int KPITCH = 144, KBUF = 64 * KPITCH, VPITCH = 144, VBUF = 64 * VPITCH, QPITCH = 144, QBUF = 64 * QPITCH;
constexpr int OFF_K = 0, OFF_V = 2 * KBUF, OFF_Q = 2 * KBUF + 2 * VBUF, ATT_LDS = OFF_Q + 8 * QBUF;
static_assert(ATT_LDS <= LDSCTL_OFF, "attention LDS");
__device__ __forceinline__ int crow(int i, int h) { return (i & 3) + 8 * (i >> 2) + 4 * h; }
#define ATT_BAR() asm volatile("s_waitcnt lgkmcnt(0)\n\ts_barrier" ::: "memory")
#define ATT_DEFER 16.0f
#define MFMA32(a, b, c) __builtin_amdgcn_mfma_f32_32x32x16_bf16((a), (b), (c), 0, 0, 0)
__device__ __forceinline__ void att_s(f32x16 (&s)[2][2], const LAS unsigned char* kb_, const LAS unsigned char* qs, int r, int h) {
#pragma unroll
    for (int ds = 0; ds < 4; ++ds) {
        bf16x8 kf[2], qf[2];
#pragma unroll
        for (int x = 0; x < 2; ++x) { kf[x] = *(const LAS bf16x8*)(kb_ + (32 * x + r) * KPITCH + 32 * ds + 16 * h); qf[x] = *(const LAS bf16x8*)(qs + (32 * x + r) * QPITCH + 32 * ds + 16 * h); }
#pragma unroll
        for (int kb = 0; kb < 2; ++kb)
#pragma unroll
            for (int qb = 0; qb < 2; ++qb) { if (ds == 0) { f32x16 z;
#pragma unroll
                    for (int i = 0; i < 16; ++i) z[i] = 0.f;
                    s[kb][qb] = MFMA32(kf[kb], qf[qb], z); } else s[kb][qb] = MFMA32(kf[kb], qf[qb], s[kb][qb]); }
    }
}
__device__ __forceinline__ void att_pv(f32x16 (&o)[2][2], const bf16x8 (&pf)[2][2][2], const LAS unsigned char* vb_, int r, int h) {
#pragma unroll
    for (int kb = 0; kb < 2; ++kb)
#pragma unroll
        for (int st = 0; st < 2; ++st)
#pragma unroll
            for (int db = 0; db < 2; ++db) { const LAS unsigned char* vp = vb_ + (32 * db + r) * VPITCH + (32 * kb + 16 * st + 4 * h) * 2; const s16x4 lo = *(const LAS s16x4*)vp, hi = *(const LAS s16x4*)(vp + 16);
                const bf16x8 vf = (bf16x8){lo[0], lo[1], lo[2], lo[3], hi[0], hi[1], hi[2], hi[3]};
#pragma unroll
                for (int qb = 0; qb < 2; ++qb) o[db][qb] = MFMA32(vf, pf[kb][st][qb], o[db][qb]); }
}
template <bool HAS_PV>
__device__ __forceinline__ void att_x(f32x16 (&o)[2][2], const bf16x8 (&pf)[2][2][2], f32x16 (&s)[2][2], const LAS unsigned char* vb_, const LAS unsigned char* kb_, const LAS unsigned char* qs, int r, int h) {
    s16x4 vlo[2][2][2], vhi[2][2][2];
    bf16x8 kf[4][2], qf[4][2];
#define ATT_LDV(kb) do { _Pragma("unroll") for (int st = 0; st < 2; ++st) _Pragma("unroll") for (int db = 0; db < 2; ++db) { const LAS unsigned char* vp = vb_ + (32 * db + r) * VPITCH + (32 * (kb) + 16 * st + 4 * h) * 2; \
        vlo[kb][st][db] = *(const LAS s16x4*)vp; vhi[kb][st][db] = *(const LAS s16x4*)(vp + 16); } } while (0)
#define ATT_LDKQ(ds) do { _Pragma("unroll") for (int x = 0; x < 2; ++x) { kf[ds][x] = *(const LAS bf16x8*)(kb_ + (32 * x + r) * KPITCH + 32 * (ds) + 16 * h); qf[ds][x] = *(const LAS bf16x8*)(qs + (32 * x + r) * QPITCH + 32 * (ds) + 16 * h); } } while (0)
#define ATT_PVMMA(kb) do { _Pragma("unroll") for (int st = 0; st < 2; ++st) _Pragma("unroll") for (int db = 0; db < 2; ++db) { \
        const bf16x8 vf = (bf16x8){vlo[kb][st][db][0], vlo[kb][st][db][1], vlo[kb][st][db][2], vlo[kb][st][db][3], vhi[kb][st][db][0], vhi[kb][st][db][1], vhi[kb][st][db][2], vhi[kb][st][db][3]}; \
        _Pragma("unroll") for (int qb = 0; qb < 2; ++qb) o[db][qb] = MFMA32(vf, pf[kb][st][qb], o[db][qb]); } } while (0)
#define ATT_SMMA(ds) do { _Pragma("unroll") for (int kb = 0; kb < 2; ++kb) _Pragma("unroll") for (int qb = 0; qb < 2; ++qb) { if ((ds) == 0) { f32x16 z; _Pragma("unroll") for (int i = 0; i < 16; ++i) z[i] = 0.f; \
        s[kb][qb] = MFMA32(kf[0][kb], qf[0][qb], z); } else s[kb][qb] = MFMA32(kf[ds][kb], qf[ds][qb], s[kb][qb]); } } while (0)
    if (HAS_PV) { ATT_LDV(0); ATT_LDV(1); __builtin_amdgcn_sched_barrier(0);
        ATT_PVMMA(0); ATT_LDKQ(0); ATT_LDKQ(1); __builtin_amdgcn_sched_barrier(0);
        ATT_PVMMA(1); ATT_LDKQ(2); ATT_LDKQ(3); __builtin_amdgcn_sched_barrier(0);
    } else { ATT_LDKQ(0); ATT_LDKQ(1); ATT_LDKQ(2); ATT_LDKQ(3); __builtin_amdgcn_sched_barrier(0); }
    ATT_SMMA(0); ATT_SMMA(1); ATT_SMMA(2); ATT_SMMA(3);
    __builtin_amdgcn_sched_barrier(0);
#undef ATT_LDV
#undef ATT_LDKQ
#undef ATT_PVMMA
#undef ATT_SMMA
}
__device__ __forceinline__ void att_softmax(f32x16 (&s)[2][2], f32x16 (&o)[2][2], bf16x8 (&pf)[2][2][2], float (&mx)[2], float (&l)[2], int j, int r, int h) {
    if (j == 0 || j == 4) {
        int rr = r, hh = h; asm volatile("" : "+v"(rr), "+v"(hh));
        const int dq = (j == 0) ? rr - 4 * hh : 4 * hh - rr;
#pragma unroll
        for (int kb = 0; kb < 2; ++kb)
#pragma unroll
            for (int qb = 0; qb < 2; ++qb)
#pragma unroll
                for (int i = 0; i < 16; ++i) { const int c = (32 * kb + (i & 3) + 8 * (i >> 2)) - 32 * qb; const bool bad = (j == 0) ? (dq > c) : (dq > -c); if (bad) s[kb][qb][i] = -1e30f; }
    }
    float mn[2]; bool grow = false;
#pragma unroll
    for (int qb = 0; qb < 2; ++qb) {
        float ra = fmaxf(fmaxf(s[0][qb][0], s[0][qb][1]), s[0][qb][2]), rb = fmaxf(fmaxf(s[1][qb][0], s[1][qb][1]), s[1][qb][2]);
#pragma unroll
        for (int i = 3; i < 15; i += 2) { ra = fmaxf(fmaxf(ra, s[0][qb][i]), s[0][qb][i + 1]); rb = fmaxf(fmaxf(rb, s[1][qb][i]), s[1][qb][i + 1]); }
        float rm = fmaxf(fmaxf(ra, rb), fmaxf(s[0][qb][15], s[1][qb][15]));
        rm = fmaxf(rm, __shfl_xor(rm, 32));
        mn[qb] = fmaxf(mx[qb], rm); grow = grow || (mn[qb] > mx[qb] + ATT_DEFER);
    }
    if (__any(grow)) {
#pragma unroll
        for (int qb = 0; qb < 2; ++qb) { const float alpha = __builtin_amdgcn_exp2f(mx[qb] - mn[qb]); mx[qb] = mn[qb]; l[qb] *= alpha;
#pragma unroll
            for (int db = 0; db < 2; ++db)
#pragma unroll
                for (int i = 0; i < 16; ++i) o[db][qb][i] *= alpha; }
    }
    if (__any(mx[0] != 0.f || mx[1] != 0.f)) {
#pragma unroll
        for (int qb = 0; qb < 2; ++qb)
#pragma unroll
            for (int i = 0; i < 16; ++i) { s[0][qb][i] -= mx[qb]; s[1][qb][i] -= mx[qb]; }
    }
#pragma unroll
    for (int qb = 0; qb < 2; ++qb) {
        float rs0 = 0.f, rs1 = 0.f;
#pragma unroll
        for (int i = 0; i < 16; ++i) { const float p0 = __builtin_amdgcn_exp2f(s[0][qb][i]), p1 = __builtin_amdgcn_exp2f(s[1][qb][i]); rs0 += p0; asm("" : "+v"(rs0)); rs1 += p1; asm("" : "+v"(rs1));
            s[0][qb][i] = p0; s[1][qb][i] = p1; }
        l[qb] += rs0 + rs1;
    }
#pragma unroll
    for (int kb = 0; kb < 2; ++kb)
#pragma unroll
        for (int st = 0; st < 2; ++st)
#pragma unroll
            for (int qb = 0; qb < 2; ++qb) { v4u pw; pw.x = cvtpk(s[kb][qb][8 * st + 0], s[kb][qb][8 * st + 1]); pw.y = cvtpk(s[kb][qb][8 * st + 2], s[kb][qb][8 * st + 3]);
                pw.z = cvtpk(s[kb][qb][8 * st + 4], s[kb][qb][8 * st + 5]); pw.w = cvtpk(s[kb][qb][8 * st + 6], s[kb][qb][8 * st + 7]); pf[kb][st][qb] = __builtin_bit_cast(bf16x8, pw); }
}
__device__ __forceinline__ void attn_unit(LAS unsigned char* lds, cgb16* Q, cgb16* Kb, cgb16* Vt, gb16* O, cgf32* sinks, int qrow0, int kvh, int nloc, int jlo, int klocbase, int kctx0, const int tid) {
    const int lane = tid & 63, r = lane & 31, h = lane >> 5, wid = __builtin_amdgcn_readfirstlane(tid >> 6);
    const int head = kvh * 8 + wid, ntiles = nloc + 4; const bool trail = wid >= 4;
    LAS unsigned char* qs = lds + OFF_Q + wid * QBUF;
    const int skey = tid >> 3, sch = tid & 7;
#define ATT_TROW(i) ((i) < nloc ? klocbase + 64 * (jlo + (i)) : kctx0 + 64 * ((i) - nloc))
#define ATT_LOADK(i) (*(const GAS v4u*)(Kb + (size_t)(ATT_TROW(i) + skey) * KVD + kvh * HD + sch * 8))
#define ATT_LOADV(i) (*(const GAS v4u*)(Vt + ((size_t)(kvh * (MT / 64) + (ATT_TROW(i) >> 6)) * 64 + skey) * 64 + sch * 8))
#define ATT_WRK(slot, v) (*(LAS v4u*)(lds + OFF_K + (slot) * KBUF + skey * KPITCH + sch * 16) = (v))
#define ATT_WRV(slot, v) (*(LAS v4u*)(lds + OFF_V + (slot) * VBUF + skey * VPITCH + sch * 16) = (v))
    v4u kreg, vreg;
    {
        v4u qv[8];
#pragma unroll
        for (int it = 0; it < 8; ++it) qv[it] = __builtin_nontemporal_load((const GAS v4u*)(Q + (size_t)(qrow0 + (lane >> 3) + 8 * it) * D + head * HD + (lane & 7) * 8));
        const v4u k0 = ATT_LOADK(0); kreg = ATT_LOADK(1); vreg = ATT_LOADV(0);
        __builtin_amdgcn_sched_barrier(0);
#pragma unroll
        for (int it = 0; it < 8; ++it) *(LAS v4u*)(qs + ((lane >> 3) + 8 * it) * QPITCH + (lane & 7) * 16) = qv[it];
        ATT_WRK(0, k0);
    }
    f32x16 o[2][2];
#pragma unroll
    for (int a = 0; a < 2; ++a)
#pragma unroll
        for (int b = 0; b < 2; ++b)
#pragma unroll
            for (int i = 0; i < 16; ++i) o[a][b][i] = 0.f;
    const float snk = sinks[head] * 1.4426950408889634f;
    const float l0 = h == 0 ? __builtin_amdgcn_exp2f(snk) : 0.f;
    float mx[2] = {0.f, 0.f}, l[2] = {l0, l0};
    bf16x8 pf[2][2][2];
    f32x16 s[2][2];
    ATT_BAR();
    if (trail) ATT_BAR();
#define ATT_STAGE(t) do { if ((t) + 1 < ntiles) ATT_WRK(((t) + 1) & 1, kreg); ATT_WRV((t) & 1, vreg); if ((t) + 2 < ntiles) kreg = ATT_LOADK((t) + 2); if ((t) + 1 < ntiles) vreg = ATT_LOADV((t) + 1); } while (0)
    ATT_STAGE(0);
    att_x<false>(o, pf, s, lds + OFF_V, lds + OFF_K, qs, r, h);
    ATT_BAR();
    att_softmax(s, o, pf, mx, l, nloc > 0 ? jlo : -1, r, h);
    ATT_BAR();
    for (int t = 1; t < ntiles; ++t) {
        ATT_STAGE(t);
        att_x<true>(o, pf, s, lds + OFF_V + ((t - 1) & 1) * VBUF, lds + OFF_K + (t & 1) * KBUF, qs, r, h);
        ATT_BAR();
        att_softmax(s, o, pf, mx, l, t < nloc ? jlo + t : -1, r, h);
        ATT_BAR();
    }
    att_pv(o, pf, lds + OFF_V + ((ntiles - 1) & 1) * VBUF, r, h);
#undef ATT_STAGE
    if (!trail) ATT_BAR();
#pragma unroll
    for (int qb = 0; qb < 2; ++qb) {
        const float lt = l[qb] + __shfl_xor(l[qb], 32), inv = 1.0f / lt;
#pragma unroll
        for (int db = 0; db < 2; ++db)
#pragma unroll
            for (int g = 0; g < 4; ++g) { v2u w; w.x = cvtpk(o[db][qb][4 * g] * inv, o[db][qb][4 * g + 1] * inv); w.y = cvtpk(o[db][qb][4 * g + 2] * inv, o[db][qb][4 * g + 3] * inv);
                *(LAS v2u*)(qs + (32 * qb + r) * QPITCH + (32 * db + 8 * g + 4 * h) * 2) = w; }
    }
    asm volatile("s_waitcnt lgkmcnt(0)" ::: "memory");
#pragma unroll
    for (int it = 0; it < 8; ++it) { const int row = (lane >> 3) + 8 * it; const v4u v = *(const LAS v4u*)(qs + row * QPITCH + (lane & 7) * 16);
        *(GAS v4u*)(O + (size_t)(qrow0 + row) * D + head * HD + (lane & 7) * 8) = v; }
    asm volatile("s_waitcnt lgkmcnt(0)" ::: "memory");
#undef ATT_TROW
#undef ATT_LOADK
#undef ATT_LOADV
#undef ATT_WRK
#undef ATT_WRV
}
}

__device__ __forceinline__ void attn_phase(Frame& F, cgb16* Q, cgb16* Kb, cgb16* Vb, gb16* O, cgf32* sinks, bool with_ctx) {
    for (int u = F.vcu; u < NB * NKVH * (SEQ / 64); u += F.G) {
        const int qt = u & 31, kvh = (u >> 5) & 3, b = u >> 7, t0 = qt * 64;
        const int jlo = 2 - qt > 0 ? 2 - qt : 0, jhi = 33 - qt < 4 ? 33 - qt : 4;
        att::attn_unit(F.lds, Q, Kb, Vb, O, sinks, b * SEQ + t0, kvh, jhi - jlo + 1, jlo, b * SEQ + t0 - 128, ML + b * CTXL, F.tid);
    }
    if (with_ctx) for (int u = F.vcu; u < NB * NKVH * (CTXL / 64); u += F.G) {
        const int qt = u & 3, kvh = (u >> 2) & 3, b = u >> 4;
        att::attn_unit(F.lds, Q, Kb, Vb, O, sinks, ML + b * CTXL + qt * 64, kvh, 0, 0, 0, ML + b * CTXL, F.tid);
    }
}

#define WSP(T, off) ((T)(F.ws + (off)))
#define FRAME_INIT(F) do { F.lds = (LAS unsigned char*)lds; F.MISC = (volatile LAS unsigned*)(F.lds + MISC_OFF); F.tid = threadIdx.x; asm volatile("" : "+v"(F.tid)); F.lane = F.tid & 63; F.wave = __builtin_amdgcn_readfirstlane(F.tid >> 6); \
    F.G = gridDim.x; F.bx = blockIdx.x; asm volatile("" : "+s"(F.bx)); F.vcu = (F.G % 8 == 0) ? (F.bx % 8) * (F.G / 8) + F.bx / 8 : F.bx; { unsigned char* w_ = args.ws; asm volatile("" : "+s"(w_)); F.ws = (GAS unsigned char*)w_; } F.ctl = (gu32*)(F.ws + WS_CTL); } while (0)
__global__ void __launch_bounds__(NWAVES * 64, 2) trunk_fwd(Args args) {
    extern __shared__ __attribute__((aligned(16))) unsigned char lds[];
    for (int u = threadIdx.x; u < (LDS_BYTES - LDSCTL_OFF) / 4; u += NWAVES * 64) ((LAS unsigned*)((LAS unsigned char*)lds + LDSCTL_OFF))[u] = 0u;
    __syncthreads();
    (void)xcd_barrier_post((unsigned*)(args.ws + WS_CTL) + CW_BAR, (volatile LAS unsigned*)((LAS unsigned char*)lds + MISC_OFF) + 8);

#define SEAM_(fillok) do { XcdBarrier bar_; unsigned char* w_ = args.ws; asm volatile("" : "+s"(w_)); bar_.bar = (unsigned*)((GAS unsigned*)(w_ + WS_CTL) + CW_BAR); bar_.x = xb_xcc_id(); bar_.st = (volatile LAS unsigned*)((LAS unsigned char*)lds + MISC_OFF) + 8; \
    if ((fillok) && fill_l >= 1 && fill_l < DEPTH) { int t_ = threadIdx.x; asm volatile("" : "+v"(t_)); xcd_barrier_fill(bar_, args, (GAS unsigned char*)w_, (LAS unsigned char*)lds, fill_l, nfill, t_); ++nfill; } else xcd_barrier(bar_); } while (0)
#define SEAM() SEAM_(false)
#define SEAM_F() SEAM_(true)

    int nfill = 0;
    int fill_l = 1;
    { Frame F; FRAME_INIT(F); p0_prologue(F, args); }
    SEAM();
    { Frame F; FRAME_INIT(F); cgf32* ada = WSP(cgf32*, WS_ADA);
        thin_phase<false>(F, MT, ThinIO{GIN(0), GIN(2), nullptr, nullptr, nullptr, nullptr, nullptr, nullptr, WSP(gb16*, WS_H), false, false, true}, ThinVec{nullptr, nullptr, ada + 1 * D, ada + 0 * D, GIN(6)}); }
    SEAM();

    for (int s = 0; s < 2 * DEPTH; ++s) {
        fill_l = (s >> 1) + 1;
        if (!(s & 1)) {
            if (!(s & 2)) {
                { Frame F; FRAME_INIT(F); pool_phase(F, MT, WSP(cgb16*, WS_H), WSP(gb16*, WS_P)); }
                SEAM();
            } else {
                { Frame F; FRAME_INIT(F); const int l = s >> 1;
                    pg8::Gemm g{WSP(cgb16*, WS_H), WSP(cgb16*, WS_WQKV) + (size_t)(l >> 1) * NQKV * D, MT, NQKV, D, D, D, 0, 0}; pg8::StaticOrder S; S.init(MT, NQKV, F.G, F.bx, WGM_QKV);
                    pg8::EpiQKV E{WSP(gb16*, WS_Q), WSP(gb16*, WS_K), WSP(gb16*, WS_V), WSP(cgf32*, WS_ROPE), ML, MT / 64, F.lds + pg8::STAGE_BYTES};
                    pg8::gemm_phase<pg8::EpiQKV, pg8::StaticOrder>(F.lds, F.tid, g, S, E); }
                SEAM_F();
                { Frame F; FRAME_INIT(F); const int l = s >> 1;
                    attn_phase(F, WSP(cgb16*, WS_Q), WSP(cgb16*, WS_K), WSP(cgb16*, WS_V), WSP(gb16*, WS_O), GIN(14) + (l >> 1) * NHEAD, l != DEPTH - 1); }
                SEAM_F();
            }
        } else {
            { Frame F; FRAME_INIT(F); const int l = s >> 1; const int Mx = (l == DEPTH - 1) ? ML : MT;
                pg8::Gemm g{WSP(cgb16*, WS_H), WSP(cgb16*, WS_WGU) + (size_t)l * NGU * D, Mx, NGU, D, D, D, 0, 0}; pg8::DynOrder S; S.init(Mx, NGU, F.G, F.bx, WGM_GU, WSP(GAS unsigned*, WS_CTL) + CW_DQ + l * 512, (volatile LAS int*)(F.lds + MISC_OFF) + 32);
                pg8::EpiSwiGLU E{WSP(gb16*, WS_ACT), DFF};
                pg8::gemm_phase<pg8::EpiSwiGLU, pg8::DynOrder, SWI_ALIGN, SWI_SP2>(F.lds, F.tid, g, S, E); }
            SEAM_F();
        }
        { Frame F; FRAME_INIT(F); const int l = s >> 1; const int Mx = (l == DEPTH - 1) ? ML : MT;
            pg8::Gemm gp; cgf32* cscale = nullptr;
            if (s & 1) gp = pg8::Gemm{WSP(cgb16*, WS_ACT), WSP(cgb16*, WS_WD) + (size_t)l * D * DFF, Mx, D, DFF, DFF, DFF, 0, 0};
            else if (s & 2) gp = pg8::Gemm{WSP(cgb16*, WS_O), WSP(cgb16*, WS_WO) + (size_t)(l >> 1) * D * D, Mx, D, D, D, D, 0, 0};
            else { gp = pg8::Gemm{WSP(cgb16*, WS_P), WSP(cgb16*, WS_WP) + (size_t)(l >> 1) * D * 512, MT, D, 512, D, 512, 2, 512}; }
            const int nparts = (gp.M > ML) ? 3 : 1, Gh = (F.G & 1) ? F.G : F.G / 2;
            for (int part = 0; part < nparts; ++part) {
                pg8::Gemm gq = gp; pg8::StaticOrder S; gb16* Op = WSP(gb16*, WS_Y);
                if (part == 0) { gq.M = ML; S.init(ML, gp.N, F.G, F.bx, WGM_PL); }
                else { const int hf = part - 1, Kh = gp.K / 2; gq.A = gp.A + (size_t)ML * gp.lda + hf * Kh; gq.Bt = gp.Bt + hf * Kh; gq.K = Kh; gq.M = MC;
                    S.init(MC, gp.N, Gh, F.bx % Gh); if (!(F.G & 1) && F.bx / Gh != hf) S.nwg = 0;
                    Op = hf ? WSP(gb16*, WS_Y2) : WSP(gb16*, WS_Y) + (size_t)ML * D; }
                pg8::EpiPlain E{Op, D, cscale};
                pg8::gemm_phase<pg8::EpiPlain, pg8::StaticOrder>(F.lds, F.tid, gq, S, E);
            } }
        SEAM_F();
        { Frame F; FRAME_INIT(F); const int l = s >> 1; if ((s & 1) && l + 1 < DEPTH) conv_drain(args, F.ws, F.lds, l + 1, F.tid); const bool lastl = (l == DEPTH - 1); const int Mx = lastl ? ML : MT;
            cgf32* adal = WSP(cgf32*, WS_ADA) + (size_t)l * 17 * NADA; const int ln = lastl ? l : l + 1; cgf32* adan = WSP(cgf32*, WS_ADA) + (size_t)ln * 17 * NADA;
            const bool odd = s & 1;
            const bool fin = (s == 2 * DEPTH - 1);
            thin_phase<true>(F, Mx, ThinIO{GIN(0), GIN(2), WSP(cgb16*, WS_XB), (gf32*)args.out, nullptr, WSP(gb16*, WS_XB), WSP(cgb16*, WS_Y), WSP(cgb16*, WS_Y2), WSP(gb16*, WS_H), s != 0, !fin, !fin},
                             ThinVec{adal + (odd ? 5 : 2) * D, (odd ? GIN(9) : GIN(7)) + l * D, odd ? adan + 1 * D : adal + 4 * D, odd ? adan + 0 * D : adal + 3 * D, odd ? GIN(6) + ln * D : GIN(8) + l * D}); }
        if (s < 2 * DEPTH - 1) SEAM();
    }
#undef IN
#undef SEAM
#undef SEAM_F
#undef SEAM_
}

constexpr int N_PHASES = 2 + 2 * (3 + 3) + 2 * (4 + 3);

extern "C" void kernel_launch(void* const* d_in, const int* in_sizes, int n_in, void* d_out, int out_size, void* d_ws, size_t ws_size, hipStream_t stream) {
    static int grid = 0;
    if (grid == 0) {
        if (n_in != 17 || in_sizes[0] != ML * D || out_size != ML * D || ws_size < WS_END) { fprintf(stderr, "kernel_launch: unexpected shapes (n_in %d, in0 %d, out %d, ws %zu); nothing launched\n", n_in, n_in > 0 ? in_sizes[0] : -1, out_size, ws_size); grid = -1; return; }
        int dev = 0, cus = 0, per_cu = 0;
        if (hipGetDevice(&dev) != hipSuccess || hipDeviceGetAttribute(&cus, hipDeviceAttributeMultiprocessorCount, dev) != hipSuccess) { fprintf(stderr, "kernel_launch: device query failed\n"); grid = -1; return; }
        if (hipFuncSetAttribute((const void*)trunk_fwd, hipFuncAttributeMaxDynamicSharedMemorySize, LDS_BYTES) != hipSuccess) { fprintf(stderr, "kernel_launch: hipFuncSetAttribute failed\n"); grid = -1; return; }
        if (hipOccupancyMaxActiveBlocksPerMultiprocessor(&per_cu, (const void*)trunk_fwd, NWAVES * 64, LDS_BYTES) != hipSuccess || per_cu < 1)
            fprintf(stderr, "kernel_launch: note: occupancy query reports %d workgroups per CU\n", per_cu);
        (void)hipGetLastError();
        grid = cus;
    }
    if (grid < 0) return;
    if (hipMemsetAsync((char*)d_ws + WS_CTL, 0, CTL_ZERO_BYTES, stream) != hipSuccess) { fprintf(stderr, "kernel_launch: memset failed\n"); return; }
    Args a{};
    for (int i = 0; i < 17; ++i) a.in[i] = (const float*)d_in[i];
    a.out = (float*)d_out; a.ws = (unsigned char*)d_ws;
    a.ph_lo = 0; a.ph_hi = N_PHASES;
    hipLaunchKernelGGL(trunk_fwd, dim3(grid), dim3(NWAVES * 64), LDS_BYTES, stream, a);
    const hipError_t le = hipPeekAtLastError();
    if (le != hipSuccess) fprintf(stderr, "kernel_launch: launch failed: %s\n", hipGetErrorName(le));
}
```
